# Optimizing an MI355X kernel written in HIP

```python
import math
import jax
import jax.numpy as jnp
from jax import lax
import numpy as np

D_MODEL = 1024
BATCH = 8
SEQ = 2048
DEPTH = 2
DEC_BATCH = 128
DEC_SEQ = 4
PAST_LEN = 16384
PAGE_SIZE = 128

EPS = 1e-6
A_HEADS = D_MODEL // 256
A_DK = 128
A_DV = 128
A_QK_W = A_HEADS * A_DK
A_V_W = A_HEADS * A_DV
A_CONV = 4
A_CONV_CH = 2 * A_QK_W + A_V_W
A_CHUNK = 64
A_IN = A_CONV_CH + A_V_W + 2 * A_HEADS
B_N = 64
B_HEADS = D_MODEL // 128
B_W = B_HEADS * B_N
B_DECAY_LORA = 64
B_AAA_LORA = 64
B_GATE_LORA = 128
B_LN_EPS = 64e-5
B_IN = 3 * B_W + B_DECAY_LORA + B_AAA_LORA + B_GATE_LORA
C_WIDTH = D_MODEL // 2
C_BLOCKS = 8
C_BLOCK = C_WIDTH // C_BLOCKS
C_CONV = 4
C_POW = 8.0
C_IN = 2 * C_WIDTH
N_BRANCH = 3
BRANCH_W = A_V_W
G_IN = N_BRANCH * D_MODEL
N_IN = A_IN + B_IN + C_IN + G_IN
D_FF = 4 * D_MODEL

kernel_name = 'hybrid_gdn_rwkv7_rglru_decode_step'


def split_cols(z, widths):
    out, off = [], 0
    for w in widths:
        out.append(z[..., off:off + w])
        off += w
    return out


def rmsnorm(x, g):
    xf = x.astype(jnp.float32)
    y = xf * lax.rsqrt(jnp.mean(xf * xf, axis=-1, keepdims=True) + EPS)
    return (y * g.astype(jnp.float32)).astype(x.dtype)


def l2norm(x):
    return x * lax.rsqrt(jnp.sum(x * x, axis=-1, keepdims=True) + EPS)


def causal_dwconv(x, buf, w):
    T = x.shape[1]
    width = w.shape[0]
    xp = jnp.concatenate([buf.astype(x.dtype), x], axis=1)
    y = xp[:, 0:T] * w[0]
    for j in range(1, width):
        y = y + xp[:, j:j + T] * w[j]
    return y, xp[:, T:]


def gated_delta_chunked(q, k, v, g, beta, S0):
    Bsz, T, H, DK = q.shape
    DV = v.shape[-1]
    C = A_CHUNK
    n = -(-T // C)
    pad = n * C - T

    def padt(a):
        return jnp.pad(a, [(0, 0), (0, pad)] + [(0, 0)] * (a.ndim - 2))

    def to_chunks(a):
        a = a.reshape((Bsz, n, C) + a.shape[2:])
        return a.transpose((1, 0, 3, 2) + tuple(range(4, a.ndim)))

    q, k, v, g, beta = [to_chunks(padt(t)) for t in (q, k, v, g, beta)]
    gc = jnp.cumsum(g, axis=-1)
    idx = jnp.arange(C)
    causal = idx[:, None] >= idx[None, :]
    strict = idx[:, None] > idx[None, :]
    decay = jnp.exp(jnp.where(causal, gc[..., :, None] - gc[..., None, :], -jnp.inf))
    kb = k * beta[..., None]
    L = jnp.where(strict, jnp.einsum('nbhid,nbhjd->nbhij', kb, k) * decay, 0.0)
    A = jnp.eye(C, dtype=jnp.float32) + L
    rhs = jnp.concatenate([v * beta[..., None], kb * jnp.exp(gc)[..., None]], axis=-1)
    sol = lax.linalg.triangular_solve(A, rhs, left_side=True, lower=True, unit_diagonal=True)
    u, w = sol[..., :DV], sol[..., DV:]
    attn = jnp.einsum('nbhid,nbhjd->nbhij', q, k) * decay
    qg = q * jnp.exp(gc)[..., None]
    kdec = k * jnp.exp(gc[..., -1:] - gc)[..., None]
    glast = jnp.exp(gc[..., -1])

    def step(S, xs):
        u_c, w_c, attn_c, qg_c, kdec_c, gl_c = xs
        vnew = u_c - jnp.einsum('bhcd,bhde->bhce', w_c, S)
        o = jnp.einsum('bhcd,bhde->bhce', qg_c, S) + jnp.einsum('bhij,bhje->bhie', attn_c, vnew)
        S = S * gl_c[..., None, None] + jnp.einsum('bhcd,bhce->bhde', kdec_c, vnew)
        return S, o

    S, o = lax.scan(step, S0, (u, w, attn, qg, kdec, glast))
    o = o.transpose(1, 0, 3, 2, 4).reshape(Bsz, n * C, H, DV)[:, :T]
    return o, S


def gdn_branch(za, conv_buf, S0, p):
    Bsz, T, _ = za.shape
    f32 = jnp.float32
    qkv, z, b_raw, a_raw = split_cols(za, (A_CONV_CH, A_V_W, A_HEADS, A_HEADS))
    qkv, new_conv = causal_dwconv(qkv, conv_buf, p['a_conv_w'])
    qkv = jax.nn.silu(qkv.astype(f32))
    q, k, v = split_cols(qkv, (A_QK_W, A_QK_W, A_V_W))
    q = l2norm(q.reshape(Bsz, T, A_HEADS, A_DK)) * (A_DK ** -0.5)
    k = l2norm(k.reshape(Bsz, T, A_HEADS, A_DK))
    v = v.reshape(Bsz, T, A_HEADS, A_DV)
    beta = jax.nn.sigmoid(b_raw.astype(f32))
    g = -jnp.exp(p['a_A_log'].astype(f32)) * jax.nn.softplus(a_raw.astype(f32) + p['a_dt_bias'])
    o, S = gated_delta_chunked(q, k, v, g, beta, S0.astype(f32))
    o = o * lax.rsqrt(jnp.mean(o * o, axis=-1, keepdims=True) + EPS)
    o = o * p['a_norm_g'] * jax.nn.silu(z.astype(f32).reshape(Bsz, T, A_HEADS, A_DV))
    return o.reshape(Bsz, T, A_V_W), S, new_conv


def rwkv7_scan(r, w, k, v, kk, a, S0):
    def step(S, xs):
        r_t, w_t, k_t, v_t, kk_t, a_t = xs
        sa = jnp.einsum('bhvk,bhk->bhv', S, -kk_t)
        S = (S * w_t[:, :, None, :] + sa[..., None] * (kk_t * a_t)[:, :, None, :]
             + v_t[..., None] * k_t[:, :, None, :])
        o = jnp.einsum('bhvk,bhk->bhv', S, r_t)
        return S, o

    xs = tuple(jnp.moveaxis(t, 1, 0) for t in (r, w, k, v, kk, a))
    S, o = lax.scan(step, S0, xs)
    return jnp.moveaxis(o, 0, 1), S


def rwkv7_branch(zb, shift_buf, S0, p):
    Bsz, T, _ = zb.shape
    f32 = jnp.float32
    zb = zb.astype(f32)
    prev = jnp.concatenate([shift_buf.astype(f32), zb[:, :-1]], axis=1)
    zs = zb + (prev - zb) * p['b_mu']
    r, k, v, xw, xa, xg = split_cols(zs, (B_W, B_W, B_W, B_DECAY_LORA, B_AAA_LORA, B_GATE_LORA))
    w_log = -jax.nn.softplus(-(p['b_w0'] + jnp.tanh(xw) @ p['b_w_up'])) - 0.5
    decay = jnp.exp(-jnp.exp(w_log))
    a = jax.nn.sigmoid(p['b_a0'] + xa @ p['b_a_up'])
    g = jax.nn.sigmoid(xg) @ p['b_g_up']
    kk = k * p['b_k_k']
    k = k * (1.0 + (a - 1.0) * p['b_k_a'])
    r, k, v, kk, a, decay = [t.reshape(Bsz, T, B_HEADS, B_N) for t in (r, k, v, kk, a, decay)]
    kk = l2norm(kk)
    o, S = rwkv7_scan(r, decay, k, v, kk, a, S0.astype(f32))
    mu = jnp.mean(o, axis=-1, keepdims=True)
    var = jnp.mean(jnp.square(o - mu), axis=-1, keepdims=True)
    o = ((o - mu) * lax.rsqrt(var + B_LN_EPS)).reshape(Bsz, T, B_W) * p['b_ln_w'] + p['b_ln_b']
    bonus = jnp.sum(r * k * p['b_r_k'], axis=-1, keepdims=True) * v
    o = o + bonus.reshape(Bsz, T, B_W)
    return o * g, S, zb[:, -1:]


def diag_linear_scan(a, b, h0):
    b = b.at[:, 0].add(a[:, 0] * h0)

    def combine(lft, rgt):
        al, bl = lft
        ar, br = rgt
        return al * ar, ar * bl + br

    _, h = lax.associative_scan(combine, (a, b), axis=1)
    return h


def rglru_branch(zc, conv_buf, h0, p):
    Bsz, T, _ = zc.shape
    f32 = jnp.float32
    xb, gb = split_cols(zc, (C_WIDTH, C_WIDTH))
    xc, new_conv = causal_dwconv(xb, conv_buf, p['c_conv_w'])
    xc = (xc + p['c_conv_b']).astype(f32)
    xblk = xc.reshape(Bsz, T, C_BLOCKS, C_BLOCK)
    r = jax.nn.sigmoid(jnp.einsum('btgi,gij->btgj', xblk, p['c_wa']).reshape(Bsz, T, C_WIDTH) + p['c_ba'])
    i = jax.nn.sigmoid(jnp.einsum('btgi,gij->btgj', xblk, p['c_wx']).reshape(Bsz, T, C_WIDTH) + p['c_bx'])
    log_a = -C_POW * r * jax.nn.softplus(-p['c_L'].astype(f32))
    a = jnp.exp(log_a)
    b = jnp.sqrt(-jnp.expm1(2.0 * log_a)) * (i * xc)
    h = diag_linear_scan(a, b, h0.astype(f32))
    y = h * jax.nn.gelu(gb.astype(f32))
    return y, h[:, -1], new_conv


def hybrid_layer(x, a_S, a_conv, b_S, b_shift, c_h, c_conv, p):
    Bsz, T, _ = x.shape
    h = rmsnorm(x, p['norm1_g'])
    z = h @ p['w_in']
    za, zb, zc, zg = split_cols(z, (A_IN, B_IN, C_IN, G_IN))
    ya, a_S, a_conv = gdn_branch(za, a_conv, a_S, p)
    yb, b_S, b_shift = rwkv7_branch(zb, b_shift, b_S, p)
    yc, c_h, c_conv = rglru_branch(zc, c_conv, c_h, p)
    br = jnp.stack([ya, yb, yc], axis=2).astype(x.dtype)
    proj = jnp.einsum('btnc,ncd->btnd', br, p['w_branch'])
    gates = jax.nn.sigmoid(zg.reshape(Bsz, T, N_BRANCH, D_MODEL))
    x = x + (jnp.sum(gates * proj, axis=2) @ p['w_out']).astype(x.dtype)
    h2 = rmsnorm(x, p['norm2_g'])
    x = x + (jnp.square(jax.nn.relu(h2 @ p['w_up'])) @ p['w_down']).astype(x.dtype)
    return x, (a_S, a_conv, b_S, b_shift, c_h, c_conv)


def setup_inputs(seed: int = 0) -> dict:
    key = jax.random.key(seed)
    ks = iter(jax.random.split(key, 48))
    nrm = lambda shape, s: jax.random.normal(next(ks), shape, jnp.float32) * s
    uni = lambda shape, lo, hi: jax.random.uniform(next(ks), shape, jnp.float32, lo, hi)
    x_prompt = nrm((BATCH, SEQ, D_MODEL), 1.0)
    x_sample = nrm((DEC_BATCH, DEC_SEQ, D_MODEL), 1.0)
    state_a_S = nrm((DEPTH, DEC_BATCH, A_HEADS, A_DK, A_DV), 0.3)
    state_a_conv = nrm((DEPTH, DEC_BATCH, A_CONV - 1, A_CONV_CH), 1.0)
    state_b_S = nrm((DEPTH, DEC_BATCH, B_HEADS, B_N, B_N), 0.3)
    state_b_shift = nrm((DEPTH, DEC_BATCH, 1, B_IN), 1.0)
    state_c_h = nrm((DEPTH, DEC_BATCH, C_WIDTH), 0.5)
    state_c_conv = nrm((DEPTH, DEC_BATCH, C_CONV - 1, C_WIDTH), 1.0)
    norm1_g = 1.0 + nrm((DEPTH, D_MODEL), 0.01)
    w_in = nrm((DEPTH, D_MODEL, N_IN), D_MODEL ** -0.5)
    a_conv_w = nrm((DEPTH, A_CONV, A_CONV_CH), A_CONV ** -0.5)
    a_A_log = jnp.log(uni((DEPTH, A_HEADS), 1.0, 16.0))
    dt = jnp.exp(uni((DEPTH, A_HEADS), math.log(1e-3), math.log(1e-1)))
    a_dt_bias = dt + jnp.log(-jnp.expm1(-dt))
    a_norm_g = 1.0 + nrm((DEPTH, A_DV), 0.01)
    b_mu = uni((DEPTH, B_IN), 0.0, 1.0)
    b_w0 = uni((DEPTH, B_W), -6.0, -1.0)
    b_w_up = nrm((DEPTH, B_DECAY_LORA, B_W), 0.1 * B_DECAY_LORA ** -0.5)
    b_a0 = nrm((DEPTH, B_W), 0.1)
    b_a_up = nrm((DEPTH, B_AAA_LORA, B_W), 0.1 * B_AAA_LORA ** -0.5)
    b_g_up = nrm((DEPTH, B_GATE_LORA, B_W), B_GATE_LORA ** -0.5)
    b_k_k = 0.85 + nrm((DEPTH, B_W), 0.01)
    b_k_a = 1.0 + nrm((DEPTH, B_W), 0.01)
    b_r_k = nrm((DEPTH, B_HEADS, B_N), 0.1)
    b_ln_w = 1.0 + nrm((DEPTH, B_W), 0.01)
    b_ln_b = nrm((DEPTH, B_W), 0.01)
    c_conv_w = nrm((DEPTH, C_CONV, C_WIDTH), C_CONV ** -0.5)
    c_conv_b = nrm((DEPTH, C_WIDTH), 0.01)
    c_wa = nrm((DEPTH, C_BLOCKS, C_BLOCK, C_BLOCK), C_BLOCK ** -0.5)
    c_ba = nrm((DEPTH, C_WIDTH), 0.01)
    c_wx = nrm((DEPTH, C_BLOCKS, C_BLOCK, C_BLOCK), C_BLOCK ** -0.5)
    c_bx = nrm((DEPTH, C_WIDTH), 0.01)
    base = uni((DEPTH, C_WIDTH), 0.9, 0.999) ** (1.0 / C_POW)
    c_L = jnp.log(base) - jnp.log1p(-base)
    w_branch = nrm((DEPTH, N_BRANCH, BRANCH_W, D_MODEL), BRANCH_W ** -0.5)
    w_out = nrm((DEPTH, D_MODEL, D_MODEL), D_MODEL ** -0.5)
    norm2_g = 1.0 + nrm((DEPTH, D_MODEL), 0.01)
    w_up = nrm((DEPTH, D_MODEL, D_FF), D_MODEL ** -0.5)
    w_down = nrm((DEPTH, D_FF, D_MODEL), 0.5 * D_FF ** -0.5)
    final_norm_g = 1.0 + nrm((D_MODEL,), 0.01)
    return {'x_prompt': x_prompt, 'x_sample': x_sample,
            'state_a_S': state_a_S, 'state_a_conv': state_a_conv,
            'state_b_S': state_b_S, 'state_b_shift': state_b_shift,
            'state_c_h': state_c_h, 'state_c_conv': state_c_conv,
            'norm1_g': norm1_g, 'w_in': w_in,
            'a_conv_w': a_conv_w, 'a_A_log': a_A_log, 'a_dt_bias': a_dt_bias, 'a_norm_g': a_norm_g,
            'b_mu': b_mu, 'b_w0': b_w0, 'b_w_up': b_w_up, 'b_a0': b_a0, 'b_a_up': b_a_up,
            'b_g_up': b_g_up, 'b_k_k': b_k_k, 'b_k_a': b_k_a, 'b_r_k': b_r_k,
            'b_ln_w': b_ln_w, 'b_ln_b': b_ln_b,
            'c_conv_w': c_conv_w, 'c_conv_b': c_conv_b, 'c_wa': c_wa, 'c_ba': c_ba,
            'c_wx': c_wx, 'c_bx': c_bx, 'c_L': c_L,
            'w_branch': w_branch, 'w_out': w_out, 'norm2_g': norm2_g,
            'w_up': w_up, 'w_down': w_down, 'final_norm_g': final_norm_g}


def reference(x_prompt, x_sample, state_a_S, state_a_conv, state_b_S, state_b_shift, state_c_h, state_c_conv,
              norm1_g, w_in, a_conv_w, a_A_log, a_dt_bias, a_norm_g,
              b_mu, b_w0, b_w_up, b_a0, b_a_up, b_g_up, b_k_k, b_k_a, b_r_k, b_ln_w, b_ln_b,
              c_conv_w, c_conv_b, c_wa, c_ba, c_wx, c_bx, c_L,
              w_branch, w_out, norm2_g, w_up, w_down, final_norm_g):
    f32 = jnp.float32
    xp, xs = x_prompt, x_sample
    Bp = x_prompt.shape[0]
    p_new = [[] for _ in range(6)]
    s_new = [[] for _ in range(6)]
    for l in range(DEPTH):
        p = {'norm1_g': norm1_g[l], 'w_in': w_in[l],
             'a_conv_w': a_conv_w[l], 'a_A_log': a_A_log[l], 'a_dt_bias': a_dt_bias[l], 'a_norm_g': a_norm_g[l],
             'b_mu': b_mu[l], 'b_w0': b_w0[l], 'b_w_up': b_w_up[l], 'b_a0': b_a0[l], 'b_a_up': b_a_up[l],
             'b_g_up': b_g_up[l], 'b_k_k': b_k_k[l], 'b_k_a': b_k_a[l], 'b_r_k': b_r_k[l],
             'b_ln_w': b_ln_w[l], 'b_ln_b': b_ln_b[l],
             'c_conv_w': c_conv_w[l], 'c_conv_b': c_conv_b[l], 'c_wa': c_wa[l], 'c_ba': c_ba[l],
             'c_wx': c_wx[l], 'c_bx': c_bx[l], 'c_L': c_L[l],
             'w_branch': w_branch[l], 'w_out': w_out[l], 'norm2_g': norm2_g[l],
             'w_up': w_up[l], 'w_down': w_down[l]}
        xp, pst = hybrid_layer(
            xp,
            jnp.zeros((Bp, A_HEADS, A_DK, A_DV), f32),
            jnp.zeros((Bp, A_CONV - 1, A_CONV_CH), xp.dtype),
            jnp.zeros((Bp, B_HEADS, B_N, B_N), f32),
            jnp.zeros((Bp, 1, B_IN), xp.dtype),
            jnp.zeros((Bp, C_WIDTH), f32),
            jnp.zeros((Bp, C_CONV - 1, C_WIDTH), xp.dtype),
            p)
        xs, sst = hybrid_layer(xs, state_a_S[l], state_a_conv[l], state_b_S[l], state_b_shift[l],
                               state_c_h[l], state_c_conv[l], p)
        for j in range(6):
            p_new[j].append(pst[j])
            s_new[j].append(sst[j])
    y_prompt = rmsnorm(xp, final_norm_g)
    y_sample = rmsnorm(xs, final_norm_g)
    return (y_prompt, y_sample,
            jnp.stack(p_new[0]), jnp.stack(p_new[1]), jnp.stack(p_new[2]),
            jnp.stack(p_new[3]), jnp.stack(p_new[4]), jnp.stack(p_new[5]),
            jnp.stack(s_new[0]), jnp.stack(s_new[1]), jnp.stack(s_new[2]),
            jnp.stack(s_new[3]), jnp.stack(s_new[4]), jnp.stack(s_new[5]))
```

```cpp
#include <hip/hip_runtime.h>
#include <cstdio>
#include <cstdint>
#include <cstddef>
#define GAS __attribute__((address_space(1)))
#define LAS __attribute__((address_space(3)))
#define CAS __attribute__((address_space(4)))
typedef unsigned short bf16;
typedef unsigned v4u __attribute__((ext_vector_type(4)));
typedef unsigned v2u __attribute__((ext_vector_type(2)));
typedef float f32x4 __attribute__((ext_vector_type(4)));
typedef float f32x2 __attribute__((ext_vector_type(2)));
typedef short bf16x8 __attribute__((ext_vector_type(8)));
typedef short bf16x4 __attribute__((ext_vector_type(4)));

constexpr int NWAVES = 8, NTHR = 512;
constexpr int D = 1024, DFF = 4096, MP = 16384, MS = 512, MROWS = MP + MS;
constexpr int SEQ = 2048, NB = 8, NSB = 128, TS = 4;
constexpr int NIN_SRC = 7944;
constexpr int NZ = 4864;
constexpr int ZA_Q = 0, ZA_K = 512, ZA_V = 1024, ZA_G = 1536, ZB_R = 2048, ZB_K = 2560, ZB_V = 3072, ZB_XW = 3584, ZB_XA = 3648, ZB_XG = 3712, ZC_X = 3840, ZC_G = 4352;
constexpr int NGATE = 3072, NWIN = NZ + NGATE;
constexpr float EPS = 1e-6f, B_LN_EPS = 64e-5f;

constexpr size_t MiB = 1u << 20;
constexpr size_t WS_CTL = 0, CTL_ZERO_BYTES = 1 * MiB;
constexpr size_t WS_WIN = 1 * MiB, WS_WBR = 17 * MiB, WS_WOUT = 20 * MiB, WS_WUP = 22 * MiB, WS_WDN = 30 * MiB, WS_MISCW = 38 * MiB;
constexpr size_t WS_XB = 39 * MiB, WS_SSQ = 72 * MiB, WS_BG = 74 * MiB, WS_HALO = 75 * MiB, WS_CSUM = 79 * MiB, WS_GL = 80 * MiB, WS_GW = 81 * MiB, WS_GATT = 97 * MiB;
constexpr size_t WS_M = 105 * MiB, WS_Z = 138 * MiB, WS_END = 295 * MiB;
static_assert(WS_Z + (size_t)MROWS * NZ * 2 <= WS_END && (size_t)MROWS * DFF * 2 <= (size_t)MROWS * NZ * 2, "ws map");
constexpr size_t MW_WSP = 0;
constexpr size_t MW_WCA = 64 * 1024;
constexpr size_t MW_WCX = 128 * 1024;
constexpr size_t HALO_A_OFF = 0;
constexpr size_t HALO_C_OFF = 3 * MiB;

constexpr int LDS_BYTES = 163840;
constexpr int MISC_OFF = LDS_BYTES - 256;

#define RLX_AGENT __ATOMIC_RELAXED, __HIP_MEMORY_SCOPE_AGENT
#define LDS_WAIT() asm volatile("s_waitcnt lgkmcnt(0)" ::: "memory")
#define VM_WAIT() asm volatile("s_waitcnt vmcnt(0)" ::: "memory")

typedef __bf16 bf16x2_t __attribute__((ext_vector_type(2)));
__device__ __forceinline__ unsigned pk2(float lo, float hi) { const f32x2 v = {lo, hi}; return __builtin_bit_cast(unsigned, __builtin_convertvector(v, bf16x2_t)); }
__device__ __forceinline__ unsigned f2bf(float f) { return pk2(f, 0.f) & 0xffffu; }
__device__ __forceinline__ float bf2f(unsigned short b) { return __builtin_bit_cast(float, ((unsigned)b) << 16); }
__device__ __forceinline__ float bflo(unsigned w) { return __builtin_bit_cast(float, w << 16); }
__device__ __forceinline__ float bfhi(unsigned w) { return __builtin_bit_cast(float, w & 0xffff0000u); }
__device__ __forceinline__ float fexp(float x) { return __expf(x); }
__device__ __forceinline__ float fsigmoid(float x) { return __builtin_amdgcn_rcpf(1.f + __expf(-x)); }
__device__ __forceinline__ float fsoftplus(float x) { return fmaxf(x, 0.f) + __logf(1.f + __expf(-fabsf(x))); }
__device__ __forceinline__ float fsilu(float x) { return x * fsigmoid(x); }
__device__ __forceinline__ float ftanh(float x) { const float e = __expf(2.f * x); return 1.f - 2.f * __builtin_amdgcn_rcpf(e + 1.f); }
__device__ __forceinline__ float fgelu(float x) { return 0.5f * x * (1.f + ftanh(0.7978845608028654f * (x + 0.044715f * x * x * x))); }
template <int CTRL> __device__ __forceinline__ float dppf(float x) { return __builtin_bit_cast(float, __builtin_amdgcn_mov_dpp(__builtin_bit_cast(int, x), CTRL, 0xf, 0xf, true)); }
__device__ __forceinline__ float sum8(float x) {
    x += dppf<0xB1>(x); x += dppf<0x4E>(x); x += dppf<0x141>(x); return x; }
__device__ __forceinline__ float sum16(float x) {
    x += dppf<0xB1>(x); x += dppf<0x4E>(x); x += dppf<0x141>(x); x += dppf<0x140>(x); return x; }
__device__ __forceinline__ float xor16f(float x) { return __builtin_bit_cast(float, __builtin_amdgcn_ds_swizzle(__builtin_bit_cast(int, x), 0x401F)); }
__device__ __forceinline__ float add_xor32(float x) {
    const auto r = __builtin_amdgcn_permlane32_swap(__builtin_bit_cast(unsigned, x), __builtin_bit_cast(unsigned, x), false, false);
    return __builtin_bit_cast(float, (unsigned)r[0]) + __builtin_bit_cast(float, (unsigned)r[1]); }
__device__ __forceinline__ float wave_sum(float v) { v = sum16(v); v += xor16f(v); return add_xor32(v); }
namespace pg8 {
#define PG8_LAS __attribute__((address_space(3)))
typedef unsigned short bf16_t;
constexpr int BM = 256, BK = 64, HALF = 128, HTB = HALF * BK * 2, STAGE_BYTES = 8 * HTB, NXCD = 8, WGM = 8;

__host__ __device__ __forceinline__ int lds_byte(int r, int c) { const int st = (r >> 4) * 2 + (c >> 5), rr = r & 15, cc = c & 31, ob = rr * 64 + cc * 2; return st * 1024 + (ob ^ (((ob >> 9) & 1) << 5)); }
__host__ __device__ __forceinline__ void stage_rc(int b, int& R, int& C) { const int st = b / 1024, sb = b % 1024, swz = sb ^ (((sb >> 9) & 1) << 5); R = (st >> 1) * 16 + swz / 64; C = (st & 1) * 32 + (swz % 64) / 2; }
__host__ __device__ __forceinline__ int perm32(int rho) { const int n = rho >> 4, i = rho & 15; return 8 * (i >> 2) + 4 * n + (i & 3); }

struct Unit { int pm, pn, aux; size_t a_off, b_off; };
struct Gemm { const bf16_t* A; int lda; const bf16_t* Bt; int K; };

struct Order {
    int nM, nN, nwg, G, c, rep;
    size_t a_tile, b_tile;
    __device__ __forceinline__ void init(int M, int N, int G_, int c_, int rep_, size_t a_tile_, size_t b_tile_) {
        nM = M / BM; nN = N / BM; nwg = nM * nN; G = G_; c = c_; rep = rep_; a_tile = a_tile_; b_tile = b_tile_;
        }
    __device__ __forceinline__ bool next(int i, Unit& u) const {
        int t = i, sub = i; if (rep == 3) { t = i / 3; sub = i - 3 * t; }
        const long L = (long)t * G + c; if (L >= nwg) return false;
        int wgid = (int)L; { const int q = nwg / NXCD, r = nwg % NXCD, xcd = wgid % NXCD, off = wgid / NXCD; wgid = (xcd < r ? xcd * (q + 1) : r * (q + 1) + (xcd - r) * q) + off; }
        const int nig = WGM * nN, gid = wgid / nig, fm = gid * WGM, gsz = (nM - fm) < WGM ? (nM - fm) : WGM;
        u.pm = fm + ((wgid % nig) % gsz); u.pn = (wgid % nig) / gsz; u.aux = sub;
        u.a_off = (size_t)u.pm * a_tile; u.b_off = (size_t)u.pn * b_tile;
        if (rep == 3) {
            u.a_off += (size_t)(3072 + 1024 * sub + (sub >> 1) * 3584); u.b_off += (size_t)sub * (1024 * 512 * 2); }
        return true;
    }
    __device__ __forceinline__ void a_ready(const Unit&) const {}
    __device__ __forceinline__ void done(const Unit&) const {}
};

__device__ __forceinline__ int gate_col(int t) { return t < 4 ? 256 * t : (t < 8 ? 2560 + 256 * (t - 4) : (t < 10 ? 1024 + 256 * (t - 8) : 3840 + 256 * (t - 10))); }
__device__ __forceinline__ unsigned cvt_pk_bf16(float lo, float hi) { const f32x2 v = {lo, hi}; return __builtin_bit_cast(unsigned, __builtin_convertvector(v, bf16x2_t)); }

__device__ __forceinline__ float row_rstd(const float* ssq, int row) {
    const f32x4* p = (const f32x4*)(ssq + (size_t)row * 16); const f32x4 a = p[0], b = p[1], c = p[2], d = p[3];
    const float s = ((a[0] + a[1]) + (a[2] + a[3])) + ((b[0] + b[1]) + (b[2] + b[3])) + ((c[0] + c[1]) + (c[2] + c[3])) + ((d[0] + d[1]) + (d[2] + d[3]));
    return __builtin_amdgcn_rsqf(s * (1.0f / 1024.0f) + 1e-6f);
}
template <int ACT> struct EpiRowScale {
    static constexpr bool PERM = true, AFTER_DRAIN = false, PREP = true;
    bf16_t* O; int ldc; const float* ssq;
    template <class Sched> __device__ __forceinline__ void prepare(PG8_LAS unsigned char* lds, const Sched& S, int tid) const {
        PG8_LAS float* tab = (PG8_LAS float*)(lds + STAGE_BYTES); Unit u;
        for (int i = 0; i < 8 && S.next(i, u); ++i) if (tid < 256) tab[i * 256 + tid] = row_rstd(ssq, u.pm * BM + tid);
        __syncthreads();
    }
    PG8_LAS unsigned char* ldsE;
    __device__ __forceinline__ void operator()(const f32x4 (&acc)[2][2][4][2], const Unit& u, int wr, int wc, int fr, int fq) const {
        const int row0 = u.pm * BM + wr * 64 + fr;
        int colt = u.pn * BM; if (ACT == 1) colt = gate_col(u.pn);
        const int col0 = colt + wc * 32 + 8 * fq;
#pragma unroll
        for (int ai = 0; ai < 2; ++ai)
#pragma unroll
            for (int m = 0; m < 4; ++m) { const int row = row0 + ai * HALF + m * 16; const float rs = ((const PG8_LAS float*)(ldsE + STAGE_BYTES))[u.aux * 256 + (row & 255)];
                bf16_t* rowp = O + (size_t)row * ldc + col0;
#pragma unroll
                for (int bj = 0; bj < 2; ++bj) { f32x4 v0 = acc[ai][bj][m][0] * rs, v1 = acc[ai][bj][m][1] * rs;
                    if (ACT == 1) {
#pragma unroll
                        for (int j = 0; j < 4; ++j) { v0[j] = __builtin_amdgcn_rcpf(1.f + __expf(-v0[j])); v1[j] = __builtin_amdgcn_rcpf(1.f + __expf(-v1[j])); } }
                    if (ACT == 2) {
#pragma unroll
                        for (int j = 0; j < 4; ++j) { const float a = fmaxf(v0[j], 0.f), b = fmaxf(v1[j], 0.f); v0[j] = a * a; v1[j] = b * b; } }
                    v4u w; w.x = cvt_pk_bf16(v0[0], v0[1]); w.y = cvt_pk_bf16(v0[2], v0[3]); w.z = cvt_pk_bf16(v1[0], v1[1]); w.w = cvt_pk_bf16(v1[2], v1[3]);
                    *(v4u*)(rowp + bj * HALF) = w; } }
    }
};
struct EpiBranch {
    static constexpr bool PERM = true, AFTER_DRAIN = false, PREP = false;
    bf16_t* Mb; const bf16_t* Zg; int ldz;
    __device__ __forceinline__ void operator()(const f32x4 (&acc)[2][2][4][2], const Unit& u, int wr, int wc, int fr, int fq) const {
        const int row0 = u.pm * BM + wr * 64 + fr; const int b = u.aux;
        const int col0 = u.pn * BM + wc * 32 + 8 * fq, g0 = gate_col(b * 4 + u.pn) + wc * 32 + 8 * fq;
#pragma unroll
        for (int ai = 0; ai < 2; ++ai)
#pragma unroll
            for (int m = 0; m < 4; ++m) { const int row = row0 + ai * HALF + m * 16;
                bf16_t* mp = Mb + (size_t)row * 1024 + col0; const bf16_t* gp = Zg + (size_t)row * ldz + g0;
                v4u gw2[2], ow2[2];
#pragma unroll
                for (int bj = 0; bj < 2; ++bj) { gw2[bj] = *(const v4u*)(gp + bj * HALF); if (b != 0) ow2[bj] = *(const v4u*)(mp + bj * HALF); }
#pragma unroll
                for (int bj = 0; bj < 2; ++bj) { const v4u gw = gw2[bj];
                    f32x4 v0 = acc[ai][bj][m][0], v1 = acc[ai][bj][m][1];
                    v0[0] *= bflo(gw.x); v0[1] *= bfhi(gw.x); v0[2] *= bflo(gw.y); v0[3] *= bfhi(gw.y);
                    v1[0] *= bflo(gw.z); v1[1] *= bfhi(gw.z); v1[2] *= bflo(gw.w); v1[3] *= bfhi(gw.w);
                    if (b != 0) { const v4u ow = ow2[bj];
                        v0[0] += bflo(ow.x); v0[1] += bfhi(ow.x); v0[2] += bflo(ow.y); v0[3] += bfhi(ow.y);
                        v1[0] += bflo(ow.z); v1[1] += bfhi(ow.z); v1[2] += bflo(ow.w); v1[3] += bfhi(ow.w); }
                    v4u w; w.x = cvt_pk_bf16(v0[0], v0[1]); w.y = cvt_pk_bf16(v0[2], v0[3]); w.z = cvt_pk_bf16(v1[0], v1[1]); w.w = cvt_pk_bf16(v1[2], v1[3]);
                    *(v4u*)(mp + bj * HALF) = w; }
                if (m & 1) asm volatile("" ::: "memory"); }
    }
};
struct EpiRes {
    static constexpr bool PERM = false, AFTER_DRAIN = false, PREP = false;
    const float* xp; const float* xs; float* out; bf16_t* xb; float* ssq;
    __device__ __forceinline__ void operator()(const f32x4 (&acc)[2][2][4][2], const Unit& u, int wr, int wc, int fr, int fq) const {
        const int row0 = u.pm * BM + wr * 64 + fr, col0 = u.pn * BM + wc * 32 + 4 * fq;
        const float* base = (u.pm < 64) ? xp + (size_t)row0 * 1024 : xs + (size_t)(row0 - 16384) * 1024;
#pragma unroll
        for (int ai = 0; ai < 2; ++ai)
#pragma unroll
            for (int m = 0; m < 4; ++m) { const size_t roff = (size_t)(ai * HALF + m * 16) * 1024 + col0; const int row = row0 + ai * HALF + m * 16;
                float ss = 0.f;
#pragma unroll
                for (int bj = 0; bj < 2; ++bj)
#pragma unroll
                    for (int n = 0; n < 2; ++n) { const f32x4 bs = *(const f32x4*)(base + roff + bj * HALF + n * 16); const f32x4 o = bs + acc[ai][bj][m][n];
                        *(f32x4*)(out + (size_t)row * 1024 + col0 + bj * HALF + n * 16) = o;
                        v2u w; w.x = cvt_pk_bf16(o[0], o[1]); w.y = cvt_pk_bf16(o[2], o[3]);
                        *(v2u*)(xb + (size_t)row * 1024 + col0 + bj * HALF + n * 16) = w;
                        ss += (o[0] * o[0] + o[1] * o[1]) + (o[2] * o[2] + o[3] * o[3]); }
                ss += xor16f(ss); ss = add_xor32(ss);
                if (fq == 0) ssq[(size_t)row * 16 + u.pn * 4 + wc] = ss;
                asm volatile("" ::: "memory"); }
    }
};

template <class Epi, class Sched, bool ALIGN_EPI = false, bool SP2 = false>
__device__ __forceinline__ void gemm_phase(PG8_LAS unsigned char* lds, const Gemm g, const Sched& S, const Epi& E) {
    int tid = threadIdx.x; asm volatile("" : "+v"(tid));
    const int wid = __builtin_amdgcn_readfirstlane(tid >> 6), lane = tid & 63, wr = wid >> 2, wc = wid & 3, fr = lane & 15, fq = lane >> 4;
    const int K = g.K, nt = K / BK, lda = g.lda;
    unsigned voffA[2], voffB[2];
#pragma unroll
    for (int i = 0; i < 2; ++i) { int R, C; stage_rc(tid * 16 + i * 8192, R, C); const int Rb = Epi::PERM ? ((R & ~31) + perm32(R & 31)) : R;
        voffA[i] = (unsigned)(R * lda + C) * 2u; voffB[i] = (unsigned)(Rb * K + C) * 2u; }
    const size_t kstep = (size_t)(BK * 2);
    const size_t hstepA = (size_t)HALF * lda * 2, hstepB = (size_t)HALF * K * 2;
    const unsigned ldsw = (unsigned)wid * 1024u;
    const int aoff = lds_byte(wr * 64 + fr, fq * 8), boff = lds_byte(wc * 32 + fr, fq * 8);
#define PG8_SA(b, h) (((b) * 2 + (h)) * HTB)
#define PG8_SB(b, h) ((4 + (b) * 2 + (h)) * HTB)
#define PG8_STAGE(bufoff, gbase, voff) do { _Pragma("unroll") for (int _i = 0; _i < 2; ++_i) \
        __builtin_amdgcn_global_load_lds((const unsigned*)((const char*)(gbase) + (voff)[_i]), (PG8_LAS unsigned*)(lds + (bufoff) + ldsw + _i * 8192), 16, 0, 0); } while (0)
#define PG8_LDA(dst, b, h) do { _Pragma("unroll") for (int m = 0; m < 4; ++m) _Pragma("unroll") for (int k = 0; k < 2; ++k) dst[m][k] = *(const PG8_LAS bf16x8*)(lds + PG8_SA(b, h) + aoff + m * 2048 + k * 1024); } while (0)
#define PG8_LDB(dst, b, h) do { _Pragma("unroll") for (int n = 0; n < 2; ++n) _Pragma("unroll") for (int k = 0; k < 2; ++k) dst[n][k] = *(const PG8_LAS bf16x8*)(lds + PG8_SB(b, h) + boff + n * 2048 + k * 1024); } while (0)
#define PG8_MMA(ai, bj, At, Bt) do { __builtin_amdgcn_s_setprio(1); _Pragma("unroll") for (int m = 0; m < 4; ++m) _Pragma("unroll") for (int n = 0; n < 2; ++n) _Pragma("unroll") for (int k = 0; k < 2; ++k) \
        acc[ai][bj][m][n] = __builtin_amdgcn_mfma_f32_16x16x32_bf16(Bt[n][k], At[m][k], acc[ai][bj][m][n], 0, 0, 0); __builtin_amdgcn_s_setprio(0); } while (0)
#define PG8_WAIT_V(n) asm volatile("s_waitcnt vmcnt(" #n ")" ::: "memory")
#define PG8_WAIT_L(n) asm volatile("s_waitcnt lgkmcnt(" #n ")" ::: "memory")
#define PG8_BAR __builtin_amdgcn_s_barrier()
#define PG8_SCHED __builtin_amdgcn_sched_barrier(0)
    if constexpr (Epi::PREP) E.prepare(lds, S, tid);
    Unit cur, nxt; int ui = 0;
    if (!S.next(0, cur)) return;
    f32x4 acc[2][2][4][2];
#pragma unroll
    for (int a = 0; a < 2; ++a)
#pragma unroll
        for (int b = 0; b < 2; ++b)
#pragma unroll
            for (int m = 0; m < 4; ++m)
#pragma unroll
                for (int n = 0; n < 2; ++n) acc[a][b][m][n] = (f32x4){0.f, 0.f, 0.f, 0.f};
    bf16x8 At[4][2], B0[2][2], B1[2][2];
    const char* cA = (const char*)g.A + cur.a_off; const char* cB = (const char*)g.Bt + cur.b_off;
    S.a_ready(cur);
    if constexpr (SP2) {
        PG8_STAGE(PG8_SB(0, 0), cB, voffB); PG8_STAGE(PG8_SB(0, 1), cB + hstepB, voffB); PG8_STAGE(PG8_SA(0, 0), cA, voffA); PG8_STAGE(PG8_SA(0, 1), cA + hstepA, voffA);
        if (wr == 1) PG8_BAR;
        PG8_WAIT_V(2); PG8_BAR;
        PG8_STAGE(PG8_SB(1, 0), cB + kstep, voffB); PG8_STAGE(PG8_SA(1, 0), cA + kstep, voffA); PG8_STAGE(PG8_SB(1, 1), cB + hstepB + kstep, voffB);
        PG8_WAIT_V(6); PG8_BAR;
    } else {
        PG8_STAGE(PG8_SB(0, 0), cB, voffB); PG8_STAGE(PG8_SA(0, 0), cA, voffA); PG8_STAGE(PG8_SB(0, 1), cB + hstepB, voffB); PG8_STAGE(PG8_SA(0, 1), cA + hstepA, voffA);
        if (wr == 1) PG8_BAR;
        PG8_WAIT_V(4); PG8_BAR;
        PG8_STAGE(PG8_SB(1, 0), cB + kstep, voffB); PG8_STAGE(PG8_SA(1, 0), cA + kstep, voffA); PG8_STAGE(PG8_SB(1, 1), cB + hstepB + kstep, voffB);
        PG8_WAIT_V(6); PG8_BAR;
    }
    for (;;) {
        const bool has_next = S.next(ui + 1, nxt);
        const char* nA = has_next ? (const char*)g.A + nxt.a_off : cA; const char* nB = has_next ? (const char*)g.Bt + nxt.b_off : cB;
        for (int t = 0; t < nt; t += 2) {
            const bool last = (t == nt - 2);
            const char* a1 = cA + (size_t)(t + 1) * kstep;
            const char* a2 = last ? nA : cA + (size_t)(t + 2) * kstep; const char* b2 = last ? nB : cB + (size_t)(t + 2) * kstep;
            const char* a3 = a2 + kstep; const char* b3 = b2 + kstep;
            if (last && has_next) S.a_ready(nxt);
            if constexpr (SP2) {
            PG8_LDB(B0, 0, 0); PG8_LDB(B1, 0, 1); PG8_SCHED; PG8_LDA(At, 0, 0); PG8_STAGE(PG8_SA(1, 1), a1 + hstepA, voffA);
            PG8_WAIT_V(8); PG8_WAIT_L(0); PG8_BAR; PG8_MMA(0, 0, At, B0); PG8_MMA(0, 1, At, B1); PG8_BAR; PG8_SCHED;
            PG8_LDA(At, 0, 1); PG8_STAGE(PG8_SB(0, 0), b2, voffB); PG8_STAGE(PG8_SB(0, 1), b2 + hstepB, voffB); PG8_STAGE(PG8_SA(0, 0), a2, voffA);
            PG8_WAIT_V(8); PG8_WAIT_L(0); PG8_BAR; PG8_MMA(1, 0, At, B0); PG8_MMA(1, 1, At, B1); PG8_BAR; PG8_SCHED;
            PG8_LDB(B0, 1, 0); PG8_LDB(B1, 1, 1); PG8_SCHED; PG8_LDA(At, 1, 0); PG8_STAGE(PG8_SA(0, 1), a2 + hstepA, voffA);
            PG8_WAIT_V(8); PG8_WAIT_L(0); PG8_BAR; PG8_MMA(0, 0, At, B0); PG8_MMA(0, 1, At, B1); PG8_BAR; PG8_SCHED;
            PG8_LDA(At, 1, 1); PG8_STAGE(PG8_SB(1, 0), b3, voffB); PG8_STAGE(PG8_SB(1, 1), b3 + hstepB, voffB); PG8_STAGE(PG8_SA(1, 0), a3, voffA);
            PG8_WAIT_V(8); PG8_WAIT_L(0); PG8_BAR; PG8_MMA(1, 0, At, B0); PG8_MMA(1, 1, At, B1); PG8_BAR; PG8_SCHED;
            } else {
            PG8_LDB(B0, 0, 0); PG8_SCHED; PG8_LDA(At, 0, 0); PG8_STAGE(PG8_SA(1, 1), a1 + hstepA, voffA);
            PG8_WAIT_L(8); PG8_BAR; PG8_WAIT_L(0); PG8_MMA(0, 0, At, B0); PG8_BAR; PG8_SCHED;
            PG8_LDB(B1, 0, 1); PG8_STAGE(PG8_SB(0, 0), b2, voffB);
            PG8_BAR; PG8_WAIT_L(0); PG8_MMA(0, 1, At, B1); PG8_BAR;
            PG8_LDA(At, 0, 1); PG8_STAGE(PG8_SA(0, 0), a2, voffA);
            PG8_BAR; PG8_WAIT_L(0); PG8_MMA(1, 0, At, B0); PG8_BAR; PG8_SCHED;
            PG8_STAGE(PG8_SB(0, 1), b2 + hstepB, voffB);
            PG8_WAIT_V(6); PG8_BAR; PG8_MMA(1, 1, At, B1); PG8_BAR;
            PG8_LDB(B0, 1, 0); PG8_SCHED; PG8_LDA(At, 1, 0); PG8_STAGE(PG8_SA(0, 1), a2 + hstepA, voffA);
            PG8_WAIT_L(8); PG8_BAR; PG8_WAIT_L(0); PG8_MMA(0, 0, At, B0); PG8_BAR; PG8_SCHED;
            PG8_LDB(B1, 1, 1); PG8_STAGE(PG8_SB(1, 0), b3, voffB);
            PG8_BAR; PG8_WAIT_L(0); PG8_MMA(0, 1, At, B1); PG8_BAR;
            PG8_LDA(At, 1, 1); PG8_STAGE(PG8_SA(1, 0), a3, voffA);
            PG8_BAR; PG8_WAIT_L(0); PG8_MMA(1, 0, At, B0); PG8_BAR; PG8_SCHED;
            PG8_STAGE(PG8_SB(1, 1), b3 + hstepB, voffB);
            PG8_WAIT_V(6); PG8_BAR; PG8_MMA(1, 1, At, B1); PG8_BAR;
            }
        }
        if constexpr (ALIGN_EPI) { if (wr == 0) PG8_BAR; }
        if constexpr (!Epi::AFTER_DRAIN) { E(acc, cur, wr, wc, fr, fq); S.done(cur); }
        if (!has_next) break;
#pragma unroll
        for (int a = 0; a < 2; ++a)
#pragma unroll
            for (int b = 0; b < 2; ++b)
#pragma unroll
                for (int m = 0; m < 4; ++m)
#pragma unroll
                    for (int n = 0; n < 2; ++n) acc[a][b][m][n] = (f32x4){0.f, 0.f, 0.f, 0.f};
        cur = nxt; cA = nA; cB = nB; ++ui;
        if constexpr (ALIGN_EPI) { if (wr == 1) PG8_BAR; }
    }
    PG8_WAIT_V(0);
    if constexpr (!ALIGN_EPI) { if (wr == 0) PG8_BAR; }
    PG8_BAR;
#undef PG8_SA
#undef PG8_SB
#undef PG8_STAGE
#undef PG8_LDA
#undef PG8_LDB
#undef PG8_MMA
#undef PG8_WAIT_V
#undef PG8_WAIT_L
#undef PG8_BAR
#undef PG8_SCHED
}
}
typedef GAS unsigned gu32;
#define XB_TMO      128
#define XB_XCNT(j)  (256  + 64 * (j))
#define XB_XSUB(j)  (1280 + 64 * (j))
#define XB_XGEN(j)  (2304 + 64 * (j))
#define XB_TOP      3328
#define XB_TOPGEN   3392
#define XCD_BAR_WORDS 3456
#define XB_SPIN_CAP (1u << 20)

__device__ __forceinline__ unsigned xb_ld(unsigned* p)              { return __hip_atomic_load(p, __ATOMIC_RELAXED, __HIP_MEMORY_SCOPE_AGENT); }
__device__ __forceinline__ unsigned xb_add(unsigned* p, unsigned v) { return __hip_atomic_fetch_add(p, v, __ATOMIC_RELAXED, __HIP_MEMORY_SCOPE_AGENT); }
__device__ __forceinline__ unsigned xb_xcc_id() { return (unsigned)__builtin_amdgcn_s_getreg((3 << 11) | 20) & 0xFu; }
#define XB_SPIN(cond, bar) do { unsigned _sp = 0; while (cond) { __builtin_amdgcn_s_sleep(1); \
    if ((++_sp & 255u) == 0u) { if (xb_ld(&(bar)[XB_TMO])) break; if (_sp > XB_SPIN_CAP) { atomicAdd(&(bar)[XB_TMO], 1u); break; } } } } while (0)

struct XcdBarrier {
    unsigned* bar; unsigned x; unsigned nparts;
    volatile LAS unsigned* st;
};
__device__ __forceinline__ XcdBarrier xcd_barrier_post(unsigned* bar, volatile LAS unsigned* st, unsigned nparts) {
    XcdBarrier b; b.bar = bar; b.x = xb_xcc_id(); b.st = st; b.nparts = nparts;
    if (threadIdx.x == 0) (void)xb_add(&bar[XB_XCNT(b.x)], 1u);
    return b;
}
__device__ __forceinline__ void xcd_barrier_complete(unsigned* bar, unsigned x, unsigned G, unsigned& nloc, unsigned& nx) {
    unsigned sum, cnt, mine, sp = 0u;
    for (;;) {
        sum = 0u; cnt = 0u; mine = 0u;
#pragma unroll
        for (unsigned j = 0; j < 16; ++j) { const unsigned c = xb_ld(&bar[XB_XCNT(j)]); sum += c; cnt += (c > 0u) ? 1u : 0u; mine = (j == x) ? c : mine; }
        if (sum == G) break;
        __builtin_amdgcn_s_sleep(1);
        if ((++sp & 255u) == 0u) { if (xb_ld(&bar[XB_TMO])) break; if (sp > XB_SPIN_CAP) { atomicAdd(&bar[XB_TMO], 1u); break; } }
    }
    nloc = mine > 0u ? mine : 1u; nx = cnt > 0u ? cnt : 1u;
}
__device__ __forceinline__ void xcd_barrier(const XcdBarrier& b0) {
    asm volatile("s_waitcnt vmcnt(0)" ::: "memory");
    __syncthreads();
    if (threadIdx.x == 0) {
        XcdBarrier b = b0; { unsigned* p = b.bar; unsigned x = b.x; asm volatile("" : "+s"(p), "+s"(x)); b.bar = p; b.x = x; }
        unsigned* bar = b.bar;
        __builtin_amdgcn_s_waitcnt(0);
        unsigned nloc = b.st[0], nx = b.st[1];
        if (nloc == 0u) { xcd_barrier_complete(bar, b.x, b.nparts, nloc, nx); b.st[0] = nloc; b.st[1] = nx; }
        const unsigned old = xb_add(&bar[XB_XSUB(b.x)], 1u);
        const unsigned gen = old / nloc;
        if (old + 1u == (gen + 1u) * nloc) {
            __builtin_amdgcn_fence(__ATOMIC_RELEASE, "agent");
            asm volatile("s_waitcnt vmcnt(0)" ::: "memory");
            const unsigned og = xb_add(&bar[XB_TOP], 1u);
            const unsigned tg = og / nx;
            if (og + 1u == (tg + 1u) * nx) xb_add(&bar[XB_TOPGEN], 1u);
            else XB_SPIN(xb_ld(&bar[XB_TOPGEN]) == tg, bar);
            __builtin_amdgcn_fence(__ATOMIC_ACQUIRE, "agent");
            xb_add(&bar[XB_XGEN(b.x)], 1u);
            asm volatile("s_waitcnt vmcnt(0)" ::: "memory");
        } else {
            XB_SPIN(xb_ld(&bar[XB_XGEN(b.x)]) == gen, bar);
            __builtin_amdgcn_fence(__ATOMIC_ACQUIRE, "agent");
            asm volatile("s_waitcnt vmcnt(0)" ::: "memory");
        }
    }
    __syncthreads();
}
constexpr size_t O_YX = 0, O_PAS = O_YX + (size_t)MROWS * D, O_PAC = O_PAS + (size_t)2 * NB * 4 * 128 * 128, O_PBS = O_PAC + (size_t)2 * NB * 3 * 1536, O_PBH = O_PBS + (size_t)2 * NB * 8 * 64 * 64,
                 O_PCH = O_PBH + (size_t)2 * NB * 1792, O_PCC = O_PCH + (size_t)2 * NB * 512, O_SAS = O_PCC + (size_t)2 * NB * 3 * 512, O_SAC = O_SAS + (size_t)2 * NSB * 4 * 128 * 128,
                 O_SBS = O_SAC + (size_t)2 * NSB * 3 * 1536, O_SBH = O_SBS + (size_t)2 * NSB * 8 * 64 * 64, O_SCH = O_SBH + (size_t)2 * NSB * 1792, O_SCC = O_SCH + (size_t)2 * NSB * 512;
struct Frame {
    LAS unsigned char* lds;
    int tid, lane, wave, G, bid;
    const float* const CAS* in;
    float* out;
    unsigned char* ws;
    int omask;
#define FPTR(name, T, expr) __device__ __forceinline__ T* name() const { return (T*)(expr); }
    FPTR(y_x, float, out + O_YX) FPTR(p_a_S, float, out + O_PAS) FPTR(p_a_conv, float, out + O_PAC) FPTR(p_b_S, float, out + O_PBS) FPTR(p_b_shift, float, out + O_PBH) FPTR(p_c_h, float, out + O_PCH) FPTR(p_c_conv, float, out + O_PCC)
    FPTR(s_a_S, float, out + O_SAS) FPTR(s_a_conv, float, out + O_SAC) FPTR(s_b_S, float, out + O_SBS) FPTR(s_b_shift, float, out + O_SBH) FPTR(s_c_h, float, out + O_SCH) FPTR(s_c_conv, float, out + O_SCC)
    FPTR(WIN, bf16, ws + WS_WIN) FPTR(WBR, bf16, ws + WS_WBR) FPTR(WOUT, bf16, ws + WS_WOUT) FPTR(WUP, bf16, ws + WS_WUP) FPTR(WDN, bf16, ws + WS_WDN)
    FPTR(WSP, float, ws + WS_MISCW + MW_WSP) FPTR(WCA, bf16, ws + WS_MISCW + MW_WCA) FPTR(WCX, bf16, ws + WS_MISCW + MW_WCX)
    FPTR(XB, bf16, ws + WS_XB) FPTR(SSQ, float, ws + WS_SSQ) FPTR(BG, float, ws + WS_BG) FPTR(HALO_A, bf16, ws + WS_HALO + HALO_A_OFF) FPTR(HALO_C, bf16, ws + WS_HALO + HALO_C_OFF)
    FPTR(CSUM, float, ws + WS_CSUM) FPTR(GL, float, ws + WS_GL) FPTR(GW, bf16, ws + WS_GW) FPTR(GATT, bf16, ws + WS_GATT) FPTR(Mb, bf16, ws + WS_M) FPTR(Z, bf16, ws + WS_Z)
#undef FPTR
};
__device__ __forceinline__ int opaque_tid(const Frame& F) { int t = F.tid; asm volatile("" : "+v"(t)); return t; }
constexpr int OM_A_S = 1, OM_A_CONV = 2, OM_B_S = 4, OM_B_SHIFT = 8, OM_C_H = 16, OM_C_CONV = 32, OM_Y = 64, OM_ALL = 127;

__device__ __forceinline__ void tr_item(const float* W, int ldw, int src_col0, int k0, const float* kscale, bf16* WT, int ldt, int dst_row0, LAS float* scr, int lane) {
    float v[32];
    const float* src = W + (size_t)(k0 + (lane >> 5)) * ldw + src_col0 + (lane & 31);
#pragma unroll
    for (int i = 0; i < 32; ++i) v[i] = src[(size_t)2 * i * ldw];
    if (kscale) {
#pragma unroll
        for (int i = 0; i < 32; ++i) v[i] *= kscale[k0 + 2 * i + (lane >> 5)]; }
#pragma unroll
    for (int i = 0; i < 32; ++i) scr[(2 * i + (lane >> 5)) * 33 + (lane & 31)] = v[i];
    LDS_WAIT(); asm volatile("" ::: "memory");
    const int c = lane & 7;
#pragma unroll
    for (int j = 0; j < 4; ++j) { const int n = (lane >> 3) + 8 * j; const LAS float* s = scr + (8 * c) * 33 + n;
        v4u o; o.x = pk2(s[0], s[33]); o.y = pk2(s[66], s[99]); o.z = pk2(s[132], s[165]); o.w = pk2(s[198], s[231]);
        *(GAS v4u*)(WT + (size_t)(dst_row0 + n) * ldt + k0 + 8 * c) = o; }
    LDS_WAIT(); asm volatile("" ::: "memory");
}
__device__ __forceinline__ void p0_weights(Frame& F, int l) {
    LAS float* scr = (LAS float*)(F.lds + F.wave * 16384);
    const int gw = F.bid * NWAVES + F.wave, NGW = F.G * NWAVES;
    const float* w_in = F.in[9] + (size_t)l * D * NIN_SRC; const float* g1 = F.in[8] + (size_t)l * D;
    const float* w_br = F.in[32] + (size_t)l * 3 * 512 * D; const float* w_out = F.in[33] + (size_t)l * D * D; const float* g2 = F.in[34] + (size_t)l * D;
    const float* w_up = F.in[35] + (size_t)l * D * DFF; const float* w_dn = F.in[36] + (size_t)l * DFF * D;
    const float* c_wa = F.in[27] + (size_t)l * 8 * 64 * 64; const float* c_wx = F.in[29] + (size_t)l * 8 * 64 * 64;
    constexpr int I_IN = 16 * 248, I_BR = 3 * 8 * 32, I_OUT = 16 * 32, I_UP = 16 * 128, I_DN = 64 * 32, I_C = 32;
    constexpr int NITEMS = I_IN + I_BR + I_OUT + I_UP + I_DN + I_C;
    for (int it = gw; it < NITEMS; it += NGW) {
        int r = it;
        if (r < I_IN) { const int kb = r / 248, nb = r % 248, n0 = nb * 32; tr_item(w_in, NIN_SRC, n0 + (n0 >= 2048 ? 8 : 0), kb * 64, g1, F.WIN(), D, n0, scr, F.lane); continue; } r -= I_IN;
        if (r < I_BR) { const int b = r / 256, q = r % 256, kb = q / 32, nb = q % 32; tr_item(w_br + (size_t)b * 512 * D, D, nb * 32, kb * 64, nullptr, F.WBR() + (size_t)b * D * 512, 512, nb * 32, scr, F.lane); continue; } r -= I_BR;
        if (r < I_OUT) { const int kb = r / 32, nb = r % 32; tr_item(w_out, D, nb * 32, kb * 64, nullptr, F.WOUT(), D, nb * 32, scr, F.lane); continue; } r -= I_OUT;
        if (r < I_UP) { const int kb = r / 128, nb = r % 128; tr_item(w_up, DFF, nb * 32, kb * 64, g2, F.WUP(), D, nb * 32, scr, F.lane); continue; } r -= I_UP;
        if (r < I_DN) { const int kb = r / 32, nb = r % 32; tr_item(w_dn, D, nb * 32, kb * 64, nullptr, F.WDN(), DFF, nb * 32, scr, F.lane); continue; } r -= I_DN;
        { const int which = r / 16, q = r % 16, g = q / 2, nb = q % 2; tr_item((which ? c_wx : c_wa) + (size_t)g * 4096, 64, nb * 32, 0, nullptr, (which ? F.WCX() : F.WCA()) + (size_t)g * 4096, 64, nb * 32, scr, F.lane); }
    }
    for (int i = F.bid * NTHR + F.tid; i < 8 * 1024; i += F.G * NTHR) { const int j = i >> 10, k = i & 1023; F.WSP()[i] = w_in[(size_t)k * NIN_SRC + 2048 + j] * g1[k]; }
}
__device__ __forceinline__ void p0_xb(Frame& F) {
    const int gw = F.bid * NWAVES + F.wave, NGW = F.G * NWAVES;
    for (int m = gw; m < MROWS; m += NGW) {
        const float* xr = (m < MP) ? F.in[0] + (size_t)m * D : F.in[1] + (size_t)(m - MP) * D;
        const f32x4* xp = (const f32x4*)xr + F.lane * 4; float s = 0.f; v4u o0, o1;
        const f32x4 a = xp[0], b = xp[1], c = xp[2], d = xp[3];
        s = (a[0] * a[0] + a[1] * a[1] + a[2] * a[2] + a[3] * a[3]) + (b[0] * b[0] + b[1] * b[1] + b[2] * b[2] + b[3] * b[3]) + (c[0] * c[0] + c[1] * c[1] + c[2] * c[2] + c[3] * c[3]) + (d[0] * d[0] + d[1] * d[1] + d[2] * d[2] + d[3] * d[3]);
        o0.x = pk2(a[0], a[1]); o0.y = pk2(a[2], a[3]); o0.z = pk2(b[0], b[1]); o0.w = pk2(b[2], b[3]);
        o1.x = pk2(c[0], c[1]); o1.y = pk2(c[2], c[3]); o1.z = pk2(d[0], d[1]); o1.w = pk2(d[2], d[3]);
        v4u* dst = (v4u*)(F.XB() + (size_t)m * D) + F.lane * 2; dst[0] = o0; dst[1] = o1;
        s = wave_sum(s);
        if (F.lane < 16) F.SSQ()[(size_t)m * 16 + F.lane] = (F.lane == 0) ? s : 0.f;
    }
}

__device__ __forceinline__ void p2_misc(Frame& F, int l) {
    const int gw = F.bid * NWAVES + F.wave, NGW = F.G * NWAVES, lane = F.lane;
    const float* A_log = F.in[11] + l * 4; const float* dtb = F.in[12] + l * 4;
    {   float wsp[8][16];
#pragma unroll
        for (int j = 0; j < 8; ++j)
#pragma unroll
            for (int e = 0; e < 16; ++e) wsp[j][e] = F.WSP()[j * 1024 + lane * 16 + e];
        for (int m = gw; m < MROWS; m += NGW) {
            const v4u* xp = (const v4u*)(F.XB() + (size_t)m * D) + lane * 2; const v4u x0 = xp[0], x1 = xp[1];
            float xv[16] = {bflo(x0.x), bfhi(x0.x), bflo(x0.y), bfhi(x0.y), bflo(x0.z), bfhi(x0.z), bflo(x0.w), bfhi(x0.w), bflo(x1.x), bfhi(x1.x), bflo(x1.y), bfhi(x1.y), bflo(x1.z), bfhi(x1.z), bflo(x1.w), bfhi(x1.w)};
            const float rs = pg8::row_rstd(F.SSQ(), m);
            float mine = 0.f;
#pragma unroll
            for (int j = 0; j < 8; ++j) { float s = 0.f;
#pragma unroll
                for (int e = 0; e < 16; ++e) s += xv[e] * wsp[j][e];
                s = wave_sum(s) * rs; if (lane == j) mine = s; }
            if (lane < 4) F.BG()[(size_t)m * 8 + lane] = fsigmoid(mine);
            else if (lane < 8) F.BG()[(size_t)m * 8 + lane] = -fexp(A_log[lane - 4]) * fsoftplus(mine + dtb[lane - 4]);
        }
    }
    for (int it = gw; it < NB * 32 * 3; it += NGW) { const int i = it % 3, c = (it / 3) % 32 + 1, b = it / 96; const size_t row = (size_t)b * SEQ + 64 * c - 3 + i;
        const bf16* zr = F.Z() + row * NZ; bf16* ha = F.HALO_A() + ((size_t)(b * 33 + c) * 3 + i) * 1536; bf16* hc = F.HALO_C() + ((size_t)(b * 33 + c) * 3 + i) * 512;
        for (int q = lane; q < 192; q += 64) ((v4u*)ha)[q] = ((const v4u*)zr)[q];
        ((v4u*)hc)[lane] = ((const v4u*)(zr + ZC_X))[lane];
        if (c == 32) {
            if (F.omask & OM_A_CONV) { float* o = F.p_a_conv() + ((size_t)(l * NB + b) * 3 + i) * 1536; for (int q = lane; q < 1536; q += 64) o[q] = bf2f(zr[q]); }
            if (F.omask & OM_C_CONV) { float* o = F.p_c_conv() + ((size_t)(l * NB + b) * 3 + i) * 512; for (int q = lane; q < 512; q += 64) o[q] = bf2f(zr[ZC_X + q]); }
        } }
    if (F.omask & OM_B_SHIFT) for (int b = gw; b < NB; b += NGW) { const bf16* zr = F.Z() + ((size_t)b * SEQ + SEQ - 1) * NZ + ZB_R; float* o = F.p_b_shift() + (size_t)(l * NB + b) * 1792; for (int q = lane; q < 1792; q += 64) o[q] = bf2f(zr[q]); }
    for (int it = gw; it < NSB * 3; it += NGW) { const int i = it % 3, sb = it / 3; const bf16* zr = F.Z() + ((size_t)MP + sb * TS + 1 + i) * NZ;
        if (F.omask & OM_A_CONV) { float* o = F.s_a_conv() + ((size_t)(l * NSB + sb) * 3 + i) * 1536; for (int q = lane; q < 1536; q += 64) o[q] = bf2f(zr[q]); }
        if (F.omask & OM_C_CONV) { float* o = F.s_c_conv() + ((size_t)(l * NSB + sb) * 3 + i) * 512; for (int q = lane; q < 512; q += 64) o[q] = bf2f(zr[ZC_X + q]); }
        if (i == 2 && (F.omask & OM_B_SHIFT)) { float* o = F.s_b_shift() + (size_t)(l * NSB + sb) * 1792; for (int q = lane; q < 1792; q += 64) o[q] = bf2f(zr[ZB_R + q]); } }
}

constexpr int RW_VEC = 0, RW_ABUF = 57344, RW_LOR = 74240, RW_KRAW = 98816, RW_OBUF = 107008, RW_PREV = 115200, RW_BON = 118784;
__device__ __forceinline__ void rwkv_unit(Frame& F, int l, int row0, int T, int h, const float* S0, const float* shift0, float* Sout) {
    const int tid = opaque_tid(F), lane = tid & 63, wv = __builtin_amdgcn_readfirstlane(tid >> 6);
    LAS float* vec = (LAS float*)(F.lds + RW_VEC); LAS bf16* abuf = (LAS bf16*)(F.lds + RW_ABUF); LAS float* lor = (LAS float*)(F.lds + RW_LOR);
    LAS float* kraw = (LAS float*)(F.lds + RW_KRAW); LAS float* obuf = (LAS float*)(F.lds + RW_OBUF); LAS float* prevb = (LAS float*)(F.lds + RW_PREV); LAS float* bon = (LAS float*)(F.lds + RW_BON);
    const float* mu = F.in[14] + (size_t)l * 1792; const float* w0 = F.in[15] + l * 512; const float* w_up = F.in[16] + (size_t)l * 64 * 512; const float* a0 = F.in[17] + l * 512;
    const float* a_up = F.in[18] + (size_t)l * 64 * 512; const float* g_up = F.in[19] + (size_t)l * 128 * 512; const float* k_k = F.in[20] + l * 512; const float* k_a = F.in[21] + l * 512;
    const float* r_k = F.in[22] + l * 512; const float* ln_w = F.in[23] + l * 512; const float* ln_b = F.in[24] + l * 512;
    const int mt = wv >> 2, nt = wv & 3, fq = lane >> 4, fr = lane & 15, hcB = h * 64 + nt * 16 + fr;
    bf16x8 Bw[2], Ba[2], Bg[4];
#pragma unroll
    for (int ks = 0; ks < 2; ++ks)
#pragma unroll
        for (int j = 0; j < 8; ++j) { const int k = 32 * ks + 8 * fq + j; Bw[ks][j] = (short)f2bf(w_up[(size_t)k * 512 + hcB]); Ba[ks][j] = (short)f2bf(a_up[(size_t)k * 512 + hcB]); }
#pragma unroll
    for (int ks = 0; ks < 4; ++ks)
#pragma unroll
        for (int j = 0; j < 8; ++j) { const int k = 32 * ks + 8 * fq + j; Bg[ks][j] = (short)f2bf(g_up[(size_t)k * 512 + hcB]); }
    const int sv = tid >> 3, sk0 = (tid & 7) * 8;
    float S[8];
#pragma unroll
    for (int j = 0; j < 8; ++j) S[j] = S0 ? S0[(size_t)sv * 64 + sk0 + j] : 0.f;
    for (int c = tid; c < 448; c += NTHR) { float p = 0.f;
        if (shift0) { const int zc = (c < 192) ? (ZB_R + (c >> 6) * 512 + h * 64 + (c & 63)) : (ZB_XW + (c - 192)); p = shift0[zc - ZB_R]; }
        prevb[c] = p; }
    __syncthreads();
    int pb = 0;
    for (int t0 = 0; t0 < T; t0 += 32) {
        const int CL = (T - t0) < 32 ? (T - t0) : 32;
        for (int qi = tid; qi < CL * 112; qi += NTHR) { const int i = qi / 112, c = (qi - i * 112) * 4;
            const int zc = (c < 192) ? (ZB_R + (c >> 6) * 512 + h * 64 + (c & 63)) : (ZB_XW + (c - 192));
            float cur[4] = {0.f, 0.f, 0.f, 0.f}, prv[4] = {0.f, 0.f, 0.f, 0.f};
            if (i < CL) { const v2u w = *(const v2u*)(F.Z() + (size_t)(row0 + t0 + i) * NZ + zc); cur[0] = bflo(w.x); cur[1] = bfhi(w.x); cur[2] = bflo(w.y); cur[3] = bfhi(w.y);
                if (i > 0) { const v2u p = *(const v2u*)(F.Z() + (size_t)(row0 + t0 + i - 1) * NZ + zc); prv[0] = bflo(p.x); prv[1] = bfhi(p.x); prv[2] = bflo(p.y); prv[3] = bfhi(p.y); }
                else { prv[0] = prevb[pb * 448 + c]; prv[1] = prevb[pb * 448 + c + 1]; prv[2] = prevb[pb * 448 + c + 2]; prv[3] = prevb[pb * 448 + c + 3]; }
                if (i == CL - 1) { prevb[(pb ^ 1) * 448 + c] = cur[0]; prevb[(pb ^ 1) * 448 + c + 1] = cur[1]; prevb[(pb ^ 1) * 448 + c + 2] = cur[2]; prevb[(pb ^ 1) * 448 + c + 3] = cur[3]; } }
            float zs[4];
#pragma unroll
            for (int j = 0; j < 4; ++j) zs[j] = cur[j] + (prv[j] - cur[j]) * mu[zc - ZB_R + j];
            if (c < 64) { LAS float* d = vec + (i * 7 + 4) * 64 + c; d[0] = zs[0]; d[1] = zs[1]; d[2] = zs[2]; d[3] = zs[3]; }
            else if (c < 128) { LAS float* d = kraw + i * 64 + (c - 64); d[0] = zs[0]; d[1] = zs[1]; d[2] = zs[2]; d[3] = zs[3]; }
            else if (c < 192) { LAS float* d = vec + (i * 7 + 5) * 64 + (c - 128); d[0] = zs[0]; d[1] = zs[1]; d[2] = zs[2]; d[3] = zs[3]; }
            else { const int cc = c - 192; float t4[4];
#pragma unroll
                for (int j = 0; j < 4; ++j) t4[j] = (cc < 64) ? ftanh(zs[j]) : ((cc < 128) ? zs[j] : fsigmoid(zs[j]));
                v2u w; w.x = pk2(t4[0], t4[1]); w.y = pk2(t4[2], t4[3]); *(LAS v2u*)(abuf + i * 264 + cc) = w; }
        }
        __syncthreads();
        {   f32x4 aw = {0.f, 0.f, 0.f, 0.f}, aa = aw, ag = aw;
            const LAS bf16* arow = abuf + (mt * 16 + fr) * 264 + 8 * fq;
#pragma unroll
            for (int ks = 0; ks < 2; ++ks) { const bf16x8 A1 = *(const LAS bf16x8*)(arow + 32 * ks), A2 = *(const LAS bf16x8*)(arow + 64 + 32 * ks);
                aw = __builtin_amdgcn_mfma_f32_16x16x32_bf16(A1, Bw[ks], aw, 0, 0, 0); aa = __builtin_amdgcn_mfma_f32_16x16x32_bf16(A2, Ba[ks], aa, 0, 0, 0); }
#pragma unroll
            for (int ks = 0; ks < 4; ++ks) { const bf16x8 A3 = *(const LAS bf16x8*)(arow + 128 + 32 * ks); ag = __builtin_amdgcn_mfma_f32_16x16x32_bf16(A3, Bg[ks], ag, 0, 0, 0); }
#pragma unroll
            for (int r = 0; r < 4; ++r) { const int tok = mt * 16 + 4 * fq + r, n = nt * 16 + fr; lor[(tok * 3 + 0) * 64 + n] = aw[r]; lor[(tok * 3 + 1) * 64 + n] = aa[r]; lor[(tok * 3 + 2) * 64 + n] = ag[r]; }
        }
        __syncthreads();
        {   const int i = tid >> 4, c0 = (tid & 15) * 4; float ss = 0.f, bs = 0.f; float kkv[4], av[4];
#pragma unroll
            for (int j = 0; j < 4; ++j) { const int c = c0 + j, hc = h * 64 + c;
                const float wl = lor[(i * 3 + 0) * 64 + c], al = lor[(i * 3 + 1) * 64 + c], gl = lor[(i * 3 + 2) * 64 + c];
                const float wlog = -fsoftplus(-(w0[hc] + wl)) - 0.5f; const float wdec = fexp(-fexp(wlog));
                const float a = fsigmoid(a0[hc] + al); const float kr = kraw[i * 64 + c]; const float kk = kr * k_k[hc];
                const float kp = kr * (1.f + (a - 1.f) * k_a[hc]);
                kkv[j] = kk; av[j] = a; ss += kk * kk; bs += vec[(i * 7 + 4) * 64 + c] * kp * r_k[hc];
                vec[(i * 7 + 1) * 64 + c] = wdec; vec[(i * 7 + 3) * 64 + c] = kp; vec[(i * 7 + 6) * 64 + c] = gl; }
            ss = sum16(ss); bs = sum16(bs); const float rn = __builtin_amdgcn_rsqf(ss + EPS);
#pragma unroll
            for (int j = 0; j < 4; ++j) { const int c = c0 + j; const float kn = kkv[j] * rn; vec[(i * 7 + 0) * 64 + c] = -kn; vec[(i * 7 + 2) * 64 + c] = kn * av[j]; }
            if ((tid & 15) == 0) bon[i] = bs;
        }
        __syncthreads();
        for (int t = 0; t < CL; ++t) {
            const LAS float* vp = vec + t * 7 * 64;
            const f32x4 n0 = *(const LAS f32x4*)(vp + 0 * 64 + sk0), n1 = *(const LAS f32x4*)(vp + 0 * 64 + sk0 + 4);
            const f32x4 w0v = *(const LAS f32x4*)(vp + 1 * 64 + sk0), w1v = *(const LAS f32x4*)(vp + 1 * 64 + sk0 + 4);
            const f32x4 a0v = *(const LAS f32x4*)(vp + 2 * 64 + sk0), a1v = *(const LAS f32x4*)(vp + 2 * 64 + sk0 + 4);
            const f32x4 k0v = *(const LAS f32x4*)(vp + 3 * 64 + sk0), k1v = *(const LAS f32x4*)(vp + 3 * 64 + sk0 + 4);
            const f32x4 r0v = *(const LAS f32x4*)(vp + 4 * 64 + sk0), r1v = *(const LAS f32x4*)(vp + 4 * 64 + sk0 + 4);
            const float vv = vp[5 * 64 + sv];
            float sa = (S[0] * n0[0] + S[1] * n0[1]) + (S[2] * n0[2] + S[3] * n0[3]) + (S[4] * n1[0] + S[5] * n1[1]) + (S[6] * n1[2] + S[7] * n1[3]);
            sa = sum8(sa);
            S[0] = S[0] * w0v[0] + sa * a0v[0] + vv * k0v[0]; S[1] = S[1] * w0v[1] + sa * a0v[1] + vv * k0v[1]; S[2] = S[2] * w0v[2] + sa * a0v[2] + vv * k0v[2]; S[3] = S[3] * w0v[3] + sa * a0v[3] + vv * k0v[3];
            S[4] = S[4] * w1v[0] + sa * a1v[0] + vv * k1v[0]; S[5] = S[5] * w1v[1] + sa * a1v[1] + vv * k1v[1]; S[6] = S[6] * w1v[2] + sa * a1v[2] + vv * k1v[2]; S[7] = S[7] * w1v[3] + sa * a1v[3] + vv * k1v[3];
            float oo = (S[0] * r0v[0] + S[1] * r0v[1]) + (S[2] * r0v[2] + S[3] * r0v[3]) + (S[4] * r1v[0] + S[5] * r1v[1]) + (S[6] * r1v[2] + S[7] * r1v[3]);
            oo = sum8(oo);
            if ((tid & 7) == 0) obuf[t * 64 + sv] = oo;
        }
        __syncthreads();
        {   const int i = tid >> 4, c0 = (tid & 15) * 4; float o4[4]; float s = 0.f;
#pragma unroll
            for (int j = 0; j < 4; ++j) { o4[j] = obuf[i * 64 + c0 + j]; s += o4[j]; }
            const float mean = sum16(s) * (1.f / 64.f); float q = 0.f;
#pragma unroll
            for (int j = 0; j < 4; ++j) { o4[j] -= mean; q += o4[j] * o4[j]; }
            const float rstd = __builtin_amdgcn_rsqf(sum16(q) * (1.f / 64.f) + B_LN_EPS); const float bo = bon[i];
            float y[4];
#pragma unroll
            for (int j = 0; j < 4; ++j) { const int c = c0 + j, hc = h * 64 + c; y[j] = (o4[j] * rstd * ln_w[hc] + ln_b[hc] + bo * vec[(i * 7 + 5) * 64 + c]) * vec[(i * 7 + 6) * 64 + c]; }
            if (i < CL) { v2u w; w.x = pk2(y[0], y[1]); w.y = pk2(y[2], y[3]); *(v2u*)(F.Z() + (size_t)(row0 + t0 + i) * NZ + ZB_R + h * 64 + c0) = w; }
        }
        __syncthreads();
        pb ^= 1;
    }
    if (F.omask & OM_B_S) {
#pragma unroll
        for (int j = 0; j < 8; ++j) Sout[(size_t)sv * 64 + sk0 + j] = S[j]; }
}

template <int I> struct SolveRows {
    static __device__ __forceinline__ void run(float (&X)[64], const LAS float* Lm, const LAS bf16* src, const LAS float* gcs, int cc, bool isk) {
        SolveRows<I - 1>::run(X, Lm, src, gcs, cc, isk);
        const float eg = gcs[128 + I]; float r = bf2f(src[I * 136 + cc]) * gcs[64 + I] * (isk ? eg : 1.0f);
#pragma unroll
        for (int j4 = 0; j4 < (I + 3) / 4; ++j4) { const f32x4 lv = *(const LAS f32x4*)(Lm + I * 64 + 4 * j4);
#pragma unroll
            for (int e = 0; e < 4; ++e) if (4 * j4 + e < I) r -= lv[e] * X[4 * j4 + e]; }
        X[I] = r; asm volatile("" ::: "memory"); }
};
template <> struct SolveRows<-1> { static __device__ __forceinline__ void run(float (&)[64], const LAS float*, const LAS bf16*, const LAS float*, int, bool) {} };
constexpr int AP_Q = 0, AP_K = 17408, AP_V = 34816, AP_L = 52224, AP_AT = 68608, AP_GC = 77824;
__device__ __forceinline__ void gdn_prep_unit(Frame& F, int l, int b, int c, int h) {
    const int tid = opaque_tid(F), lane = tid & 63, wv = __builtin_amdgcn_readfirstlane(tid >> 6);
    LAS bf16* qs = (LAS bf16*)(F.lds + AP_Q); LAS bf16* ks = (LAS bf16*)(F.lds + AP_K); LAS bf16* vs = (LAS bf16*)(F.lds + AP_V);
    LAS float* Lm = (LAS float*)(F.lds + AP_L); LAS bf16* at = (LAS bf16*)(F.lds + AP_AT); LAS float* gcs = (LAS float*)(F.lds + AP_GC);
    const float* conv_w = F.in[10] + (size_t)l * 4 * 1536;
    const size_t t0 = (size_t)b * SEQ + 64 * c; const int unit = (b * 32 + c) * 4 + h;
    {   const int tok = tid >> 3, cg = tid & 7;
#pragma unroll
        for (int seg = 0; seg < 3; ++seg) { const int col = seg * 512 + h * 128 + cg * 16; float acc[16];
#pragma unroll
            for (int e = 0; e < 16; ++e) acc[e] = 0.f;
#pragma unroll
            for (int tap = 0; tap < 4; ++tap) { const int j = tok + tap - 3; v4u x0 = {0u, 0u, 0u, 0u}, x1 = x0;
                if (j >= 0) { const v4u* p = (const v4u*)(F.Z() + (t0 + j) * NZ + col); x0 = p[0]; x1 = p[1]; }
                else if (c > 0) { const v4u* p = (const v4u*)(F.HALO_A() + ((size_t)(b * 33 + c) * 3 + (3 + j)) * 1536 + col); x0 = p[0]; x1 = p[1]; }
                const f32x4* wp = (const f32x4*)(conv_w + tap * 1536 + col); const f32x4 wa = wp[0], wb = wp[1], wc = wp[2], wd = wp[3];
                acc[0] += bflo(x0.x) * wa[0]; acc[1] += bfhi(x0.x) * wa[1]; acc[2] += bflo(x0.y) * wa[2]; acc[3] += bfhi(x0.y) * wa[3];
                acc[4] += bflo(x0.z) * wb[0]; acc[5] += bfhi(x0.z) * wb[1]; acc[6] += bflo(x0.w) * wb[2]; acc[7] += bfhi(x0.w) * wb[3];
                acc[8] += bflo(x1.x) * wc[0]; acc[9] += bfhi(x1.x) * wc[1]; acc[10] += bflo(x1.y) * wc[2]; acc[11] += bfhi(x1.y) * wc[3];
                acc[12] += bflo(x1.z) * wd[0]; acc[13] += bfhi(x1.z) * wd[1]; acc[14] += bflo(x1.w) * wd[2]; acc[15] += bfhi(x1.w) * wd[3]; }
            float ss = 0.f;
#pragma unroll
            for (int e = 0; e < 16; ++e) { acc[e] = fsilu(acc[e]); ss += acc[e] * acc[e]; }
            float sc = 1.f;
            if (seg < 2) { ss = sum8(ss); sc = __builtin_amdgcn_rsqf(ss + EPS); if (seg == 0) sc *= 0.08838834764831845f; }
            v4u o0, o1; o0.x = pk2(acc[0] * sc, acc[1] * sc); o0.y = pk2(acc[2] * sc, acc[3] * sc); o0.z = pk2(acc[4] * sc, acc[5] * sc); o0.w = pk2(acc[6] * sc, acc[7] * sc);
            o1.x = pk2(acc[8] * sc, acc[9] * sc); o1.y = pk2(acc[10] * sc, acc[11] * sc); o1.z = pk2(acc[12] * sc, acc[13] * sc); o1.w = pk2(acc[14] * sc, acc[15] * sc);
            LAS bf16* dst = (seg == 0 ? qs : (seg == 1 ? ks : vs)) + tok * 136 + cg * 16; *(LAS v4u*)dst = o0; *(LAS v4u*)(dst + 8) = o1; }
    }
    if (wv == 0) { const float g0 = F.BG()[(t0 + lane) * 8 + 4 + h]; const float be = F.BG()[(t0 + lane) * 8 + h];
        gcs[192 + lane] = g0; LDS_WAIT();
        float g = 0.f, glast = 0.f;
#pragma unroll 8
        for (int j = 0; j < 64; ++j) { const float v = gcs[192 + j]; glast += v; g += (j <= lane) ? v : 0.f; }
        LDS_WAIT();
        gcs[lane] = g; gcs[64 + lane] = be; gcs[128 + lane] = fexp(g); gcs[192 + lane] = fexp(glast - g);
        if (lane == 63) F.GL()[unit] = fexp(g); }
    __syncthreads();
    {   const int p = wv >> 2, mt = wv & 3, fq = lane >> 4, fr = lane & 15;
        const LAS bf16* Ar = (p == 0 ? ks : qs) + (mt * 16 + fr) * 136 + 8 * fq;
#pragma unroll
        for (int nt = 0; nt < 4; ++nt) { f32x4 acc = {0.f, 0.f, 0.f, 0.f};
            if (nt <= mt) { const LAS bf16* Br = ks + (nt * 16 + fr) * 136 + 8 * fq;
#pragma unroll
                for (int kst = 0; kst < 4; ++kst) acc = __builtin_amdgcn_mfma_f32_16x16x32_bf16(*(const LAS bf16x8*)(Ar + 32 * kst), *(const LAS bf16x8*)(Br + 32 * kst), acc, 0, 0, 0); }
#pragma unroll
            for (int r = 0; r < 4; ++r) { const int i = mt * 16 + 4 * fq + r, j = nt * 16 + fr; const float dec = fexp(fminf(gcs[i] - gcs[j], 0.f));
                if (p == 0) Lm[i * 64 + j] = (i > j) ? gcs[64 + i] * acc[r] * dec : 0.f;
                else at[i * 72 + j] = (bf16)f2bf((i >= j) ? acc[r] * dec : 0.f); } }
    }
    __syncthreads();
    if (tid < 256) {
        float X[64]; const int cc = tid & 127;
        SolveRows<63>::run(X, Lm, (tid < 128) ? vs : ks, gcs, cc, tid >= 128);
        if (tid < 128) {
#pragma unroll
            for (int i = 0; i < 64; ++i) F.Z()[(t0 + i) * NZ + ZA_V + h * 128 + cc] = (bf16)f2bf(X[i]); }
        else {
#pragma unroll
            for (int i = 0; i < 64; ++i) F.GW()[(size_t)unit * 8192 + i * 128 + cc] = (bf16)f2bf(X[i]); }
    } else {
        const int t2 = tid - 256;
        for (int ch = t2; ch < 1024; ch += 256) { const int i = ch >> 4, d0 = (ch & 15) * 8; const v4u q = *(const LAS v4u*)(qs + i * 136 + d0); const float e = gcs[128 + i];
            v4u o; o.x = pk2(bflo(q.x) * e, bfhi(q.x) * e); o.y = pk2(bflo(q.y) * e, bfhi(q.y) * e); o.z = pk2(bflo(q.z) * e, bfhi(q.z) * e); o.w = pk2(bflo(q.w) * e, bfhi(q.w) * e);
            *(v4u*)(F.Z() + (t0 + i) * NZ + ZA_Q + h * 128 + d0) = o; }
        for (int ch = t2; ch < 1024; ch += 256) { const int kd = ch >> 3, tg = ch & 7; float v[8];
#pragma unroll
            for (int j = 0; j < 8; ++j) v[j] = bf2f(ks[(8 * tg + j) * 136 + kd]) * gcs[192 + 8 * tg + j];
            v4u o; o.x = pk2(v[0], v[1]); o.y = pk2(v[2], v[3]); o.z = pk2(v[4], v[5]); o.w = pk2(v[6], v[7]);
            *(v4u*)(F.Z() + (t0 + (kd >> 1)) * NZ + ZA_K + h * 128 + (kd & 1) * 64 + 8 * tg) = o; }
        for (int ch = t2; ch < 512; ch += 256) { const int i = ch >> 3, j0 = (ch & 7) * 8; *(v4u*)(F.GATT() + (size_t)unit * 4096 + i * 64 + j0) = *(const LAS v4u*)(at + i * 72 + j0); }
    }
    __syncthreads();
}

constexpr int AS_W = 0, AS_QG = 17408, AS_U = 34816, AS_KT = 52224, AS_AT = 70656, AS_G = 79872, AS_PS = 97280, AS_RS = 99328;
__device__ __forceinline__ bf16x8 frag_perm(const LAS bf16* rowp) {
    const bf16x4 lo = *(const LAS bf16x4*)rowp, hi = *(const LAS bf16x4*)(rowp + 16);
    return (bf16x8){lo[0], lo[1], lo[2], lo[3], hi[0], hi[1], hi[2], hi[3]};
}
__device__ __forceinline__ bf16x8 pack_acc(const f32x4 a, const f32x4 b) {
    const unsigned w0 = pg8::cvt_pk_bf16(a[0], a[1]), w1 = pg8::cvt_pk_bf16(a[2], a[3]), w2 = pg8::cvt_pk_bf16(b[0], b[1]), w3 = pg8::cvt_pk_bf16(b[2], b[3]);
    const v4u w = {w0, w1, w2, w3}; return __builtin_bit_cast(bf16x8, w);
}
__device__ __forceinline__ void gdn_scan_unit(Frame& F, int l, int b, int h) {
    const int tid = opaque_tid(F), lane = tid & 63, e = __builtin_amdgcn_readfirstlane(tid >> 6), fq = lane >> 4, fr = lane & 15, dv = 16 * e + fr;
    LAS bf16* wS = (LAS bf16*)(F.lds + AS_W); LAS bf16* qgS = (LAS bf16*)(F.lds + AS_QG); LAS bf16* uS = (LAS bf16*)(F.lds + AS_U);
    LAS bf16* ktS = (LAS bf16*)(F.lds + AS_KT); LAS bf16* atS = (LAS bf16*)(F.lds + AS_AT); LAS bf16* gS = (LAS bf16*)(F.lds + AS_G);
    LAS float* ps = (LAS float*)(F.lds + AS_PS); LAS float* rsv = (LAS float*)(F.lds + AS_RS);
    const float ng = (F.in[13] + l * 128)[dv];
    f32x4 S[8];
#pragma unroll
    for (int t = 0; t < 8; ++t) S[t] = (f32x4){0.f, 0.f, 0.f, 0.f};
    v4u pw[2], pq[2], pu[2], pk[2], pg[2], pa; float pgl;
    const int i0 = tid >> 4, d0 = (tid & 15) * 8;
#define AS_FETCH(c) do { const size_t _t0 = (size_t)b * SEQ + 64 * (c); const int _un = (b * 32 + (c)) * 4 + h; \
        _Pragma("unroll") for (int _j = 0; _j < 2; ++_j) { const int _i = i0 + 32 * _j; const bf16* _zr = F.Z() + (_t0 + _i) * NZ + h * 128 + d0; \
            pw[_j] = *(const v4u*)(F.GW() + (size_t)_un * 8192 + _i * 128 + d0); pq[_j] = *(const v4u*)(_zr + ZA_Q); pu[_j] = *(const v4u*)(_zr + ZA_V); pk[_j] = *(const v4u*)(_zr + ZA_K); pg[_j] = *(const v4u*)(_zr + ZA_G); } \
        pa = *(const v4u*)(F.GATT() + (size_t)_un * 4096 + (tid >> 3) * 64 + (tid & 7) * 8); pgl = F.GL()[_un]; } while (0)
    AS_FETCH(0);
    float yprev[4][4];
    for (int c = 0; c < 32; ++c) {
        const size_t t0 = (size_t)b * SEQ + 64 * c;
#pragma unroll
        for (int j = 0; j < 2; ++j) { const int i = i0 + 32 * j;
            *(LAS v4u*)(wS + i * 136 + d0) = pw[j]; *(LAS v4u*)(qgS + i * 136 + d0) = pq[j]; *(LAS v4u*)(uS + i * 136 + d0) = pu[j]; *(LAS v4u*)(gS + i * 136 + d0) = pg[j];
            { const int part = tid & 15; *(LAS v4u*)(ktS + (2 * i + (part >> 3)) * 72 + (part & 7) * 8) = pk[j]; } }
        *(LAS v4u*)(atS + (tid >> 3) * 72 + (tid & 7) * 8) = pa;
        const float glast = pgl;
        __syncthreads();
        if (c > 0) {
#pragma unroll
            for (int mt = 0; mt < 4; ++mt)
#pragma unroll
                for (int r = 0; r < 4; ++r) F.Z()[(t0 - 64 + 16 * mt + 4 * fq + r) * NZ + ZA_G + h * 128 + dv] = (bf16)f2bf(yprev[mt][r]); }
        if (c + 1 < 32) AS_FETCH(c + 1);
        bf16x8 Sb[4];
#pragma unroll
        for (int kt = 0; kt < 4; ++kt) Sb[kt] = pack_acc(S[2 * kt], S[2 * kt + 1]);
        f32x4 vn[4], oo[4];
#pragma unroll
        for (int mt = 0; mt < 4; ++mt) { f32x4 pw_ = {0.f, 0.f, 0.f, 0.f}, po = pw_;
            bf16x8 fw[4], fqg[4];
#pragma unroll
            for (int kt = 0; kt < 4; ++kt) { fw[kt] = frag_perm(wS + (16 * mt + fr) * 136 + 32 * kt + 4 * fq); fqg[kt] = frag_perm(qgS + (16 * mt + fr) * 136 + 32 * kt + 4 * fq); }
            float u4[4];
#pragma unroll
            for (int r = 0; r < 4; ++r) u4[r] = bf2f(uS[(16 * mt + 4 * fq + r) * 136 + dv]);
#pragma unroll
            for (int kt = 0; kt < 4; ++kt) { pw_ = __builtin_amdgcn_mfma_f32_16x16x32_bf16(fw[kt], Sb[kt], pw_, 0, 0, 0); po = __builtin_amdgcn_mfma_f32_16x16x32_bf16(fqg[kt], Sb[kt], po, 0, 0, 0); }
#pragma unroll
            for (int r = 0; r < 4; ++r) vn[mt][r] = u4[r] - pw_[r];
            oo[mt] = po; }
        bf16x8 Vb[2];
        Vb[0] = pack_acc(vn[0], vn[1]); Vb[1] = pack_acc(vn[2], vn[3]);
        {   bf16x8 fat[4][2];
#pragma unroll
            for (int mt = 0; mt < 4; ++mt)
#pragma unroll
                for (int k2 = 0; k2 < 2; ++k2) fat[mt][k2] = frag_perm(atS + (16 * mt + fr) * 72 + 32 * k2 + 4 * fq);
#pragma unroll
            for (int mt = 0; mt < 4; ++mt)
#pragma unroll
                for (int k2 = 0; k2 < 2; ++k2) oo[mt] = __builtin_amdgcn_mfma_f32_16x16x32_bf16(fat[mt][k2], Vb[k2], oo[mt], 0, 0, 0); }
#pragma unroll
        for (int th = 0; th < 2; ++th) { bf16x8 fkt[4][2];
#pragma unroll
            for (int t = 0; t < 4; ++t)
#pragma unroll
                for (int k2 = 0; k2 < 2; ++k2) fkt[t][k2] = frag_perm(ktS + (16 * (4 * th + t) + fr) * 72 + 32 * k2 + 4 * fq);
#pragma unroll
            for (int t = 0; t < 4; ++t) { f32x4 a = S[4 * th + t] * glast;
#pragma unroll
                for (int k2 = 0; k2 < 2; ++k2) a = __builtin_amdgcn_mfma_f32_16x16x32_bf16(fkt[t][k2], Vb[k2], a, 0, 0, 0);
                S[4 * th + t] = a; } }
        float gate[4][4];
#pragma unroll
        for (int mt = 0; mt < 4; ++mt)
#pragma unroll
            for (int r = 0; r < 4; ++r) { gate[mt][r] = bf2f(gS[(16 * mt + 4 * fq + r) * 136 + dv]); const float q = sum16(oo[mt][r] * oo[mt][r]); if (fr == 0) ps[e * 64 + 16 * mt + 4 * fq + r] = q; }
        __syncthreads();
        if (tid < 64) { float s = 0.f;
#pragma unroll
            for (int w = 0; w < 8; ++w) s += ps[w * 64 + tid];
            rsv[tid] = __builtin_amdgcn_rsqf(s * (1.f / 128.f) + EPS); }
        __syncthreads();
#pragma unroll
        for (int mt = 0; mt < 4; ++mt)
#pragma unroll
            for (int r = 0; r < 4; ++r) { const int tok = 16 * mt + 4 * fq + r; yprev[mt][r] = oo[mt][r] * rsv[tok] * ng * fsilu(gate[mt][r]); }
        __syncthreads();
    }
    {   const size_t t0 = (size_t)b * SEQ + 64 * 32;
#pragma unroll
        for (int mt = 0; mt < 4; ++mt)
#pragma unroll
            for (int r = 0; r < 4; ++r) F.Z()[(t0 - 64 + 16 * mt + 4 * fq + r) * NZ + ZA_G + h * 128 + dv] = (bf16)f2bf(yprev[mt][r]); }
#undef AS_FETCH
    if (F.omask & OM_A_S) { float* o = F.p_a_S() + ((size_t)(l * NB + b) * 4 + h) * 128 * 128;
#pragma unroll
        for (int t = 0; t < 8; ++t)
#pragma unroll
            for (int r = 0; r < 4; ++r) o[(size_t)(16 * t + 4 * fq + r) * 128 + dv] = S[t][r]; }
}

constexpr int GS_QKV = 0, GS_PART = 2048, GS_PART2 = 4096, GS_RED = 6144;
__device__ __forceinline__ void gdn_sample_unit(Frame& F, int l, int sb, int h) {
    const int tid = opaque_tid(F), lane = tid & 63, wv = __builtin_amdgcn_readfirstlane(tid >> 6), dv = tid & 127, kg = tid >> 7;
    LAS float* qkv = (LAS float*)(F.lds + GS_QKV); LAS float* part = (LAS float*)(F.lds + GS_PART); LAS float* part2 = (LAS float*)(F.lds + GS_PART2); LAS float* red = (LAS float*)(F.lds + GS_RED);
    const float* conv_w = F.in[10] + (size_t)l * 4 * 1536; const float* cst = F.in[3] + ((size_t)l * NSB + sb) * 3 * 1536;
    const float* S0 = F.in[2] + (((size_t)l * NSB + sb) * 4 + h) * 128 * 128; const float ng = (F.in[13] + l * 128)[dv];
    float S[32];
#pragma unroll
    for (int j = 0; j < 32; ++j) S[j] = S0[(size_t)(32 * kg + j) * 128 + dv];
    for (int t = 0; t < TS; ++t) {
        const size_t row = (size_t)MP + sb * TS + t;
        if (tid < 384) { const int seg = tid >> 7, col = seg * 512 + h * 128 + dv; float y = 0.f;
#pragma unroll
            for (int tap = 0; tap < 4; ++tap) { const int j = t + tap - 3; const float x = (j >= 0) ? bf2f(F.Z()[((size_t)MP + sb * TS + j) * NZ + col]) : cst[(size_t)(j + 3) * 1536 + col]; y += x * conv_w[tap * 1536 + col]; }
            y = fsilu(y); qkv[seg * 128 + dv] = y;
            if (seg < 2) { const float ss = wave_sum(y * y); if (lane == 0) red[wv] = ss; } }
        __syncthreads();
        const float rnq = __builtin_amdgcn_rsqf(red[0] + red[1] + EPS) * 0.08838834764831845f, rnk = __builtin_amdgcn_rsqf(red[2] + red[3] + EPS);
        const float beta = F.BG()[row * 8 + h], eg = fexp(F.BG()[row * 8 + 4 + h]);
        float pd = 0.f;
#pragma unroll
        for (int j = 0; j < 32; ++j) { S[j] *= eg; pd += S[j] * qkv[128 + 32 * kg + j]; }
        part[kg * 128 + dv] = pd * rnk;
        __syncthreads();
        const float tot = (part[dv] + part[128 + dv]) + (part[256 + dv] + part[384 + dv]);
        const float dd = beta * (qkv[256 + dv] - tot) * rnk; float po = 0.f;
#pragma unroll
        for (int j = 0; j < 32; ++j) { S[j] += qkv[128 + 32 * kg + j] * dd; po += S[j] * qkv[32 * kg + j]; }
        part2[kg * 128 + dv] = po * rnq;
        __syncthreads();
        float o = 0.f;
        if (kg == 0) { o = (part2[dv] + part2[128 + dv]) + (part2[256 + dv] + part2[384 + dv]); const float ss = wave_sum(o * o); if (lane == 0) red[4 + wv] = ss; }
        __syncthreads();
        if (kg == 0) { const float rs = __builtin_amdgcn_rsqf((red[4] + red[5]) * (1.f / 128.f) + EPS); bf16* gp = F.Z() + row * NZ + ZA_G + h * 128 + dv;
            *gp = (bf16)f2bf(o * rs * ng * fsilu(bf2f(*gp))); }
        __syncthreads();
    }
    if (F.omask & OM_A_S) { float* o = F.s_a_S() + (((size_t)l * NSB + sb) * 4 + h) * 128 * 128;
#pragma unroll
        for (int j = 0; j < 32; ++j) o[(size_t)(32 * kg + j) * 128 + dv] = S[j]; }
}

constexpr int CP_XA = 0, CP_RI = 66560;
template <bool SAMPLE>
__device__ __forceinline__ void rglru_prep_unit(Frame& F, int l, int b, int c) {
    const int tid = opaque_tid(F), lane = tid & 63, g = __builtin_amdgcn_readfirstlane(tid >> 6), fq = lane >> 4, fr = lane & 15, ch = tid;
    LAS bf16* xa = (LAS bf16*)(F.lds + CP_XA); LAS float* ri = (LAS float*)(F.lds + CP_RI);
    const float* cw = F.in[25] + (size_t)l * 4 * 512; const float cb = (F.in[26] + l * 512)[ch];
    const float* ba = F.in[28] + l * 512; const float* bx = F.in[30] + l * 512; const float cL = (F.in[31] + l * 512)[ch];
    const size_t t0 = SAMPLE ? (size_t)MP + 64 * b : (size_t)b * SEQ + 64 * c;
    const float w0 = cw[ch], w1 = cw[512 + ch], w2 = cw[1024 + ch], w3 = cw[1536 + ch];
    {   float xm3 = 0.f, xm2 = 0.f, xm1 = 0.f;
        if (!SAMPLE && c > 0) { const bf16* hp = F.HALO_C() + (size_t)(b * 33 + c) * 3 * 512 + ch; xm3 = bf2f(hp[0]); xm2 = bf2f(hp[512]); xm1 = bf2f(hp[1024]); }
#pragma unroll 1
        for (int tb = 0; tb < 64; tb += 16) { float xr[16];
#pragma unroll
            for (int t = 0; t < 16; ++t) xr[t] = bf2f(F.Z()[(t0 + tb + t) * NZ + ZC_X + ch]);
#pragma unroll
            for (int t = 0; t < 16; ++t) {
                if (SAMPLE && (t & 3) == 0) { const float* sp = F.in[7] + ((size_t)l * NSB + 16 * b + ((tb + t) >> 2)) * 3 * 512 + ch; xm3 = sp[0]; xm2 = sp[512]; xm1 = sp[1024]; }
                const float x = xr[t];
                const float v = w0 * xm3 + w1 * xm2 + w2 * xm1 + w3 * x + cb; xm3 = xm2; xm2 = xm1; xm1 = x;
                xa[(tb + t) * 520 + ch] = (bf16)f2bf(v); } } }
    bf16x8 Ba[4][2], Bx[4][2];
#pragma unroll
    for (int nt = 0; nt < 4; ++nt)
#pragma unroll
        for (int ks = 0; ks < 2; ++ks) { Ba[nt][ks] = *(const bf16x8*)(F.WCA() + (size_t)g * 4096 + (16 * nt + fr) * 64 + 32 * ks + 8 * fq); Bx[nt][ks] = *(const bf16x8*)(F.WCX() + (size_t)g * 4096 + (16 * nt + fr) * 64 + 32 * ks + 8 * fq); }
    const float sp = fsoftplus(-cL);
    float P = 1.f, hl = 0.f;
    __syncthreads();
#pragma unroll
    for (int mt = 0; mt < 4; ++mt) {
        {   f32x4 ar[4], ai[4];
#pragma unroll
            for (int nt = 0; nt < 4; ++nt) { ar[nt] = (f32x4){0.f, 0.f, 0.f, 0.f}; ai[nt] = ar[nt]; }
#pragma unroll
            for (int ks = 0; ks < 2; ++ks) { const bf16x8 A = *(const LAS bf16x8*)(xa + (16 * mt + fr) * 520 + g * 64 + 32 * ks + 8 * fq);
#pragma unroll
                for (int nt = 0; nt < 4; ++nt) { ar[nt] = __builtin_amdgcn_mfma_f32_16x16x32_bf16(A, Ba[nt][ks], ar[nt], 0, 0, 0); ai[nt] = __builtin_amdgcn_mfma_f32_16x16x32_bf16(A, Bx[nt][ks], ai[nt], 0, 0, 0); } }
#pragma unroll
            for (int nt = 0; nt < 4; ++nt) { const int co = g * 64 + 16 * nt + fr; const float bav = ba[co], bxv = bx[co];
#pragma unroll
                for (int r = 0; r < 4; ++r) { const int tl = 4 * fq + r; *(LAS f32x2*)(ri + (tl * 512 + co) * 2) = (f32x2){fsigmoid(ar[nt][r] + bav), fsigmoid(ai[nt][r] + bxv)}; } }
        }
        __syncthreads();
        float gbv[16];
#pragma unroll
        for (int tl = 0; tl < 16; ++tl) gbv[tl] = bf2f(F.Z()[(t0 + 16 * mt + tl) * NZ + ZC_G + ch]);
#pragma unroll
        for (int tl = 0; tl < 16; ++tl) { const int t = 16 * mt + tl; const f32x2 rv = *(const LAS f32x2*)(ri + (tl * 512 + ch) * 2);
            const float log_a = -8.f * rv[0] * sp; const float a = fexp(log_a); const float bb = sqrtf(fmaxf(-expm1f(2.f * log_a), 0.f)) * (rv[1] * bf2f(xa[t * 520 + ch]));
            bf16* gp = F.Z() + (t0 + t) * NZ + ZC_G + ch; const float ge = fgelu(gbv[tl]);
            if (SAMPLE) {
                if ((t & 3) == 0) hl = (F.in[6] + ((size_t)l * NSB + 16 * b + (t >> 2)) * 512)[ch];
                hl = a * hl + bb; *gp = (bf16)f2bf(hl * ge);
                if ((t & 3) == 3 && (F.omask & OM_C_H)) (F.s_c_h() + ((size_t)l * NSB + 16 * b + (t >> 2)) * 512)[ch] = hl;
            } else { P *= a; hl = a * hl + bb; F.Z()[(t0 + t) * NZ + ZC_X + ch] = (bf16)f2bf(P * ge); *gp = (bf16)f2bf(hl * ge); } }
        __syncthreads();
    }
    if (!SAMPLE) { float* cs = F.CSUM() + ((size_t)(b * 32 + c) * 512 + ch) * 2; cs[0] = P; cs[1] = hl; }
}
__device__ __forceinline__ void rglru_fix_unit(Frame& F, int l, int b, int c) {
    const int ch = opaque_tid(F); float carry = 0.f;
    {   f32x2 cs[31];
#pragma unroll
        for (int j = 0; j < 31; ++j) cs[j] = (j < c) ? *(const f32x2*)(F.CSUM() + ((size_t)(b * 32 + j) * 512 + ch) * 2) : (f32x2){1.f, 0.f};
#pragma unroll
        for (int j = 0; j < 31; ++j) carry = cs[j][0] * carry + cs[j][1]; }
    const size_t t0 = (size_t)b * SEQ + 64 * c;
#pragma unroll 1
    for (int tb = 0; tb < 64; tb += 16) { float a1[16], a2[16];
#pragma unroll
        for (int t = 0; t < 16; ++t) { const bf16* p = F.Z() + (t0 + tb + t) * NZ; a1[t] = bf2f(p[ZC_X + ch]); a2[t] = bf2f(p[ZC_G + ch]); }
#pragma unroll
        for (int t = 0; t < 16; ++t) F.Z()[(t0 + tb + t) * NZ + ZC_G + ch] = (bf16)f2bf(a1[t] * carry + a2[t]); }
    if (c == 31 && (F.omask & OM_C_H)) { const float* cs = F.CSUM() + ((size_t)(b * 32 + 31) * 512 + ch) * 2; (F.p_c_h() + (size_t)(l * NB + b) * 512)[ch] = cs[0] * carry + cs[1]; }
}
typedef short bf16x4s __attribute__((ext_vector_type(4)));
__device__ __forceinline__ f32x4 mfma16(bf16x4s a, bf16x4s b, f32x4 c) { return __builtin_amdgcn_mfma_f32_16x16x16bf16_1k(a, b, c, 0, 0, 0); }
__device__ __forceinline__ bf16x4s cvt4(const f32x4 a) { const v2u w = {pg8::cvt_pk_bf16(a[0], a[1]), pg8::cvt_pk_bf16(a[2], a[3])}; return __builtin_bit_cast(bf16x4s, w); }
constexpr int RC_ABUF = 0, RC_RF = 16896, RC_KRAW = 25088, RC_VF = 33280, RC_LOR = 41472, RC_LW = 66048, RC_PV = 74240, RC_PG = 82432, RC_PR = 90624, RC_PK = 98816,
              RC_AH = 107008, RC_BH = 111616, RC_KH = 116224, RC_RH = 120832, RC_AHT = 125440, RC_BTT = 129536, RC_KTT = 133632, RC_VT = 137728, RC_GC = 141824, RC_RN = 142336, RC_OB = 142464, RC_PREV = 150656, RC_MU = 154240;
__device__ __forceinline__ f32x4 add_eye(f32x4 x, int fq, int fr) {
#pragma unroll
    for (int r = 0; r < 4; ++r) x[r] += (4 * fq + r == fr) ? 1.f : 0.f;
    return x; }
__device__ __forceinline__ void rwkv_chain_chunked(Frame& F, int l, int b, int h) {
    const int tid = opaque_tid(F), lane0 = tid & 63, wv = __builtin_amdgcn_readfirstlane(tid >> 6);
#define RC_LANE() int lane = lane0; asm volatile("" : "+v"(lane)); const int fq = lane >> 4, fr = lane & 15; (void)fq; (void)fr
    const int hc = h * 64 + lane0;
    LAS unsigned char* L = F.lds;
    LAS bf16* abuf = (LAS bf16*)(L + RC_ABUF); LAS float* rf = (LAS float*)(L + RC_RF); LAS float* kraw = (LAS float*)(L + RC_KRAW); LAS float* vf = (LAS float*)(L + RC_VF);
    LAS float* lor = (LAS float*)(L + RC_LOR); LAS float* LW = (LAS float*)(L + RC_LW); LAS float* PV = (LAS float*)(L + RC_PV); LAS float* PG = (LAS float*)(L + RC_PG);
    LAS float* PR = (LAS float*)(L + RC_PR); LAS float* PK = (LAS float*)(L + RC_PK); LAS float* RN = (LAS float*)(L + RC_RN);
    LAS bf16* AH = (LAS bf16*)(L + RC_AH); LAS bf16* BH = (LAS bf16*)(L + RC_BH); LAS bf16* KH = (LAS bf16*)(L + RC_KH); LAS bf16* RH = (LAS bf16*)(L + RC_RH);
    LAS bf16* AHT = (LAS bf16*)(L + RC_AHT); LAS bf16* BTT = (LAS bf16*)(L + RC_BTT); LAS bf16* KTT = (LAS bf16*)(L + RC_KTT); LAS bf16* VT = (LAS bf16*)(L + RC_VT); LAS float* GC = (LAS float*)(L + RC_GC);
    LAS float* OB = (LAS float*)(L + RC_OB); LAS float* prevb = (LAS float*)(L + RC_PREV); LAS float* muL = (LAS float*)(L + RC_MU);
    const float* mu = F.in[14] + (size_t)l * 1792; const float* w_up = F.in[16] + (size_t)l * 64 * 512; const float* a_up = F.in[18] + (size_t)l * 64 * 512; const float* g_up = F.in[19] + (size_t)l * 128 * 512;
    const float w0c = (F.in[15] + l * 512)[hc], a0c = (F.in[17] + l * 512)[hc], kkc = (F.in[20] + l * 512)[hc], kac = (F.in[21] + l * 512)[hc];
    const float* k_k = F.in[20] + l * 512; const float* r_k = F.in[22] + l * 512; const float* ln_w = F.in[23] + l * 512; const float* ln_b = F.in[24] + l * 512;
    const size_t row0 = (size_t)b * SEQ;
    const int nt = wv & 3, half = wv >> 2;
    bf16x8 Bq[4];
    { RC_LANE(); const int hcB = h * 64 + nt * 16 + fr;
    if (half == 0) {
#pragma unroll
        for (int ks = 0; ks < 2; ++ks)
#pragma unroll
            for (int j = 0; j < 8; ++j) { const int k = 32 * ks + 8 * fq + j; Bq[ks][j] = (short)f2bf(w_up[(size_t)k * 512 + hcB]); Bq[2 + ks][j] = (short)f2bf(a_up[(size_t)k * 512 + hcB]); }
    } else {
#pragma unroll
        for (int ks = 0; ks < 4; ++ks)
#pragma unroll
            for (int j = 0; j < 8; ++j) { const int k = 32 * ks + 8 * fq + j; Bq[ks][j] = (short)f2bf(g_up[(size_t)k * 512 + hcB]); }
    } }
    f32x4 ST[4];
#pragma unroll
    for (int kt = 0; kt < 4; ++kt) ST[kt] = (f32x4){0.f, 0.f, 0.f, 0.f};
    for (int c = tid; c < 896; c += NTHR) prevb[c] = 0.f;
    const int t2 = tid - 256, e1i = (t2 >> 4) & 15, lq = t2 & 15;
    v2u cq[14], pq[14]; f32x4 kk4r = {0.f, 0.f, 0.f, 0.f};
#define RC_ZCOLJ(j) (((j) < 3) ? (ZB_R + (j) * 512 + h * 64 + 4 * lq) : (ZB_XW + ((j) - 3) * 64 + 4 * lq))
#define RC_PREFETCH(t0) do { if (wv >= 4) { _Pragma("unroll") for (int s2 = 0; s2 < 2; ++s2) _Pragma("unroll") for (int j = 0; j < 7; ++j) { const int zc = RC_ZCOLJ(j), i = 16 * s2 + e1i; \
        cq[7 * s2 + j] = *(const v2u*)(F.Z() + (row0 + (t0) + i) * NZ + zc); pq[7 * s2 + j] = *(const v2u*)(F.Z() + (row0 + (t0) + (i > 0 ? i - 1 : 0)) * NZ + zc); } } } while (0)
#define RC_E1(pb) do { if (wv >= 4) { _Pragma("unroll") for (int s2 = 0; s2 < 2; ++s2) _Pragma("unroll") for (int j = 0; j < 7; ++j) { const int cc = 64 * j + 4 * lq, i = 16 * s2 + e1i; \
        const v2u cw = cq[7 * s2 + j], pw2 = pq[7 * s2 + j]; \
        float cur[4] = {bflo(cw.x), bfhi(cw.x), bflo(cw.y), bfhi(cw.y)}, prv[4] = {bflo(pw2.x), bfhi(pw2.x), bflo(pw2.y), bfhi(pw2.y)}; \
        if (s2 == 0) { const f32x4 pl = *(const LAS f32x4*)(prevb + (pb) * 448 + cc); if (e1i == 0) { prv[0] = pl[0]; prv[1] = pl[1]; prv[2] = pl[2]; prv[3] = pl[3]; } } \
        if (s2 == 1) { if (e1i == 15) *(LAS f32x4*)(prevb + ((pb) ^ 1) * 448 + cc) = (f32x4){cur[0], cur[1], cur[2], cur[3]}; } \
        const f32x4 m4 = *(const LAS f32x4*)(muL + cc); float zs[4]; _Pragma("unroll") for (int e = 0; e < 4; ++e) zs[e] = cur[e] + (prv[e] - cur[e]) * m4[e]; \
        if (j < 3) { LAS float* d = (j == 0 ? rf : (j == 1 ? kraw : vf)) + i * 64 + 4 * lq; *(LAS f32x4*)d = (f32x4){zs[0], zs[1], zs[2], zs[3]}; \
            if (j == 1) { const f32x4 kk4 = kk4r; float ss = (zs[0] * kk4[0]) * (zs[0] * kk4[0]) + (zs[1] * kk4[1]) * (zs[1] * kk4[1]) + (zs[2] * kk4[2]) * (zs[2] * kk4[2]) + (zs[3] * kk4[3]) * (zs[3] * kk4[3]); \
                ss = sum16(ss); if (lq == 0) RN[i] = __builtin_amdgcn_rsqf(ss + EPS); } } \
        else { float t4[4]; _Pragma("unroll") for (int e = 0; e < 4; ++e) t4[e] = (j == 3) ? ftanh(zs[e]) : ((j == 4) ? zs[e] : fsigmoid(zs[e])); \
            v2u w; w.x = pk2(t4[0], t4[1]); w.y = pk2(t4[2], t4[3]); *(LAS v2u*)(abuf + i * 264 + (j - 3) * 64 + 4 * lq) = w; } } } } while (0)
    const int pc0 = (tid & 15) * 4;
    const f32x4 p_rk = *(const f32x4*)(r_k + h * 64 + pc0), p_lw = *(const f32x4*)(ln_w + h * 64 + pc0), p_lb = *(const f32x4*)(ln_b + h * 64 + pc0);
#define RC_POST(tp) do { int tq = tid; asm volatile("" : "+v"(tq)); const int t = tq >> 4, c0 = (tq & 15) * 4; \
        f32x4 o4 = *(const LAS f32x4*)(OB + t * 64 + c0); const f32x4 r4 = *(const LAS f32x4*)(PR + t * 64 + c0), k4 = *(const LAS f32x4*)(PK + t * 64 + c0), v4 = *(const LAS f32x4*)(PV + t * 64 + c0), g4 = *(const LAS f32x4*)(PG + t * 64 + c0); \
        const float bs = sum16((r4[0] * k4[0] * p_rk[0] + r4[1] * k4[1] * p_rk[1]) + (r4[2] * k4[2] * p_rk[2] + r4[3] * k4[3] * p_rk[3])); \
        const float mean = sum16((o4[0] + o4[1]) + (o4[2] + o4[3])) * (1.f / 64.f); o4 = o4 - mean; \
        const float rstd = __builtin_amdgcn_rsqf(sum16((o4[0] * o4[0] + o4[1] * o4[1]) + (o4[2] * o4[2] + o4[3] * o4[3])) * (1.f / 64.f) + B_LN_EPS); \
        const f32x4 y = (o4 * rstd * p_lw + p_lb + v4 * bs) * g4; \
        v2u w; w.x = pk2(y[0], y[1]); w.y = pk2(y[2], y[3]); *(v2u*)(F.Z() + (row0 + (tp) + t) * NZ + ZB_R + h * 64 + c0) = w; } while (0)
    for (int c = tid; c < 448; c += NTHR) muL[c] = mu[((c < 192) ? ((c >> 6) * 512 + h * 64 + (c & 63)) : (1536 + (c - 192)))];
    if (wv >= 4) kk4r = *(const f32x4*)(k_k + h * 64 + 4 * lq);
    __syncthreads();
    RC_PREFETCH(0);
    RC_E1(0);
    __syncthreads();
    int pb = 1;
    for (int t0 = 0; t0 < SEQ; t0 += 32) {
        if (t0 > 0) RC_POST(t0 - 32);
        if (t0 + 32 < SEQ) RC_PREFETCH(t0 + 32);
        {   RC_LANE();
#pragma unroll
            for (int mt = 0; mt < 2; ++mt) { const LAS bf16* arow = abuf + (16 * mt + fr) * 264 + 8 * fq;
                if (half == 0) { f32x4 aw = {0.f, 0.f, 0.f, 0.f}, aa = aw;
#pragma unroll
                    for (int ks = 0; ks < 2; ++ks) { aw = __builtin_amdgcn_mfma_f32_16x16x32_bf16(*(const LAS bf16x8*)(arow + 32 * ks), Bq[ks], aw, 0, 0, 0);
                        aa = __builtin_amdgcn_mfma_f32_16x16x32_bf16(*(const LAS bf16x8*)(arow + 64 + 32 * ks), Bq[2 + ks], aa, 0, 0, 0); }
#pragma unroll
                    for (int r = 0; r < 4; ++r) { const int tok = 16 * mt + 4 * fq + r, n = nt * 16 + fr; lor[(tok * 3 + 0) * 64 + n] = aw[r]; lor[(tok * 3 + 1) * 64 + n] = aa[r]; }
                } else { f32x4 ag = {0.f, 0.f, 0.f, 0.f};
#pragma unroll
                    for (int ks = 0; ks < 4; ++ks) ag = __builtin_amdgcn_mfma_f32_16x16x32_bf16(*(const LAS bf16x8*)(arow + 128 + 32 * ks), Bq[ks], ag, 0, 0, 0);
#pragma unroll
                    for (int r = 0; r < 4; ++r) { const int tok = 16 * mt + 4 * fq + r, n = nt * 16 + fr; lor[(tok * 3 + 2) * 64 + n] = ag[r]; } } }
        }
        __syncthreads();
        float e_lw[4], e_a[4], e_kn[4], e_kp[4], e_r[4];
        { RC_LANE();
#pragma unroll
        for (int u = 0; u < 4; ++u) { const int t = 4 * wv + u;
            const float wl = lor[(t * 3 + 0) * 64 + lane], al = lor[(t * 3 + 1) * 64 + lane], gl = lor[(t * 3 + 2) * 64 + lane];
            const float wlog = -fsoftplus(-(w0c + wl)) - 0.5f; e_lw[u] = -fexp(wlog);
            e_a[u] = fsigmoid(a0c + al); const float kr = kraw[t * 64 + lane];
            e_kn[u] = kr * kkc * RN[t]; e_kp[u] = kr * (1.f + (e_a[u] - 1.f) * kac); e_r[u] = rf[t * 64 + lane];
            LW[t * 64 + lane] = e_lw[u]; PG[t * 64 + lane] = gl; PV[t * 64 + lane] = vf[t * 64 + lane]; PR[t * 64 + lane] = e_r[u]; PK[t * 64 + lane] = e_kp[u]; } }
        __syncthreads();
        {   RC_LANE(); const int sub = wv >> 2, tl0 = 4 * (wv & 3); float cum = 0.f, cumA[4] = {0.f, 0.f, 0.f, 0.f};
#pragma unroll
            for (int i = 0; i < 16; ++i) { cum += LW[(16 * sub + i) * 64 + lane];
#pragma unroll
                for (int u = 0; u < 4; ++u) if (i == tl0 + u) cumA[u] = cum; }
            const float cumC = cum;
#pragma unroll
            for (int u = 0; u < 4; ++u) { const int t = 4 * wv + u, tl = tl0 + u; const float ct = cumA[u];
                const float gm = fexp(ct - e_lw[u]), gi = fexp(-ct), gt = fexp(ct), gr = fexp(cumC - ct);
                const float ah = -e_kn[u] * gm, bh = e_kn[u] * e_a[u] * gi, kh = e_kp[u] * gi, rh = e_r[u] * gt, bt = e_kn[u] * e_a[u] * gr, kt = e_kp[u] * gr;
                AH[t * 72 + lane] = (bf16)f2bf(ah); BH[t * 72 + lane] = (bf16)f2bf(bh); KH[t * 72 + lane] = (bf16)f2bf(kh); RH[t * 72 + lane] = (bf16)f2bf(rh);
                AHT[sub * 1024 + lane * 16 + tl] = (bf16)f2bf(ah); BTT[sub * 1024 + lane * 16 + tl] = (bf16)f2bf(bt); KTT[sub * 1024 + lane * 16 + tl] = (bf16)f2bf(kt); VT[sub * 1024 + lane * 16 + tl] = (bf16)f2bf(PV[t * 64 + lane]); }
            if ((wv & 3) == 0) GC[sub * 64 + lane] = fexp(cumC);
        }
        __syncthreads();
        if (wv < 4 && !(F.omask & (1 << 22))) { RC_LANE(); const int e = wv;
#pragma unroll 1
          for (int sub = 0; sub < 2; ++sub) {
            const LAS bf16* AHs = AH + 16 * sub * 72; const LAS bf16* BHs = BH + 16 * sub * 72; const LAS bf16* KHs = KH + 16 * sub * 72; const LAS bf16* RHs = RH + 16 * sub * 72;
            const LAS bf16* AHTs = AHT + sub * 1024; const LAS bf16* BTTs = BTT + sub * 1024; const LAS bf16* KTTs = KTT + sub * 1024; const LAS bf16* VTs = VT + sub * 1024;
            bf16x8 fa[2], fb[2], fk[2], fr8[2];
#pragma unroll
            for (int ks = 0; ks < 2; ++ks) { fa[ks] = *(const LAS bf16x8*)(AHs + fr * 72 + 32 * ks + 8 * fq); fb[ks] = *(const LAS bf16x8*)(BHs + fr * 72 + 32 * ks + 8 * fq);
                fk[ks] = *(const LAS bf16x8*)(KHs + fr * 72 + 32 * ks + 8 * fq); fr8[ks] = *(const LAS bf16x8*)(RHs + fr * 72 + 32 * ks + 8 * fq); }
            const f32x4 z4 = {0.f, 0.f, 0.f, 0.f};
            f32x4 N = z4, NT = z4, Nak = z4, Nrb = z4, Nrk = z4;
#pragma unroll
            for (int ks = 0; ks < 2; ++ks) { N = __builtin_amdgcn_mfma_f32_16x16x32_bf16(fb[ks], fa[ks], N, 0, 0, 0); NT = __builtin_amdgcn_mfma_f32_16x16x32_bf16(fa[ks], fb[ks], NT, 0, 0, 0);
                Nak = __builtin_amdgcn_mfma_f32_16x16x32_bf16(fk[ks], fa[ks], Nak, 0, 0, 0); Nrb = __builtin_amdgcn_mfma_f32_16x16x32_bf16(fb[ks], fr8[ks], Nrb, 0, 0, 0);
                Nrk = __builtin_amdgcn_mfma_f32_16x16x32_bf16(fk[ks], fr8[ks], Nrk, 0, 0, 0); }
#pragma unroll
            for (int r = 0; r < 4; ++r) { const int rw = 4 * fq + r; if (!(rw < fr)) { N[r] = 0.f; Nak[r] = 0.f; } if (!(rw > fr)) NT[r] = 0.f; if (!(rw <= fr)) { Nrb[r] = 0.f; Nrk[r] = 0.f; } }
            const bf16x4s n_ = cvt4(N), nt_ = cvt4(NT);
            const f32x4 N2 = mfma16(nt_, n_, z4), N2T = mfma16(n_, nt_, z4);
            const bf16x4s n2_ = cvt4(N2), n2t_ = cvt4(N2T);
            const f32x4 N4 = mfma16(n2t_, n2_, z4), N4T = mfma16(n2_, n2t_, z4);
            const f32x4 N8 = mfma16(cvt4(N4T), cvt4(N4), z4);
            const f32x4 UT = mfma16(cvt4(add_eye(N2, fq, fr)), cvt4(add_eye(NT, fq, fr)), z4);
            const f32x4 WT = mfma16(cvt4(add_eye(N4, fq, fr)), cvt4(UT), z4);
            const f32x4 T = mfma16(cvt4(WT), cvt4(add_eye(N8, fq, fr)), z4);
            const bf16x4s t_ = cvt4(T);
            bf16x4s p1[4];
#pragma unroll
            for (int kt = 0; kt < 4; ++kt) p1[kt] = cvt4(mfma16(*(const LAS bf16x4s*)(AHTs + (16 * kt + fr) * 16 + 4 * fq), t_, z4));
            const bf16x4s vtf = *(const LAS bf16x4s*)(VTs + (16 * e + fr) * 16 + 4 * fq);
            const f32x4 nakv = mfma16(cvt4(Nak), vtf, z4);
            f32x4 sa = mfma16(t_, cvt4(nakv), z4);
            f32x4 o = mfma16(cvt4(Nrk), vtf, z4);
            bf16x4s sb[4];
#pragma unroll
            for (int kt = 0; kt < 4; ++kt) sb[kt] = cvt4(ST[kt]);
#pragma unroll
            for (int kt = 0; kt < 4; ++kt) { sa = mfma16(p1[kt], sb[kt], sa); o = mfma16(*(const LAS bf16x4s*)(RHs + fr * 72 + 16 * kt + 4 * fq), sb[kt], o); }
            const bf16x4s sab = cvt4(sa);
            o = mfma16(cvt4(Nrb), sab, o);
#pragma unroll
            for (int r = 0; r < 4; ++r) OB[(16 * sub + 4 * fq + r) * 64 + 16 * e + fr] = o[r];
#pragma unroll
            for (int kt = 0; kt < 4; ++kt) { const f32x4 g4 = *(const LAS f32x4*)(GC + 64 * sub + 16 * kt + 4 * fq); f32x4 a = ST[kt] * g4;
                a = mfma16(*(const LAS bf16x4s*)(BTTs + (16 * kt + fr) * 16 + 4 * fq), sab, a); a = mfma16(*(const LAS bf16x4s*)(KTTs + (16 * kt + fr) * 16 + 4 * fq), vtf, a); ST[kt] = a; }
          }
        } else if (t0 + 32 < SEQ && wv >= 4 && !(F.omask & (1 << 23))) { RC_E1(pb); }
        __syncthreads();
        pb ^= 1;
    }
    RC_POST(SEQ - 32);
    if ((F.omask & OM_B_S) && wv < 4) { RC_LANE(); float* o = F.p_b_S() + ((size_t)(l * NB + b) * 8 + h) * 4096;
#pragma unroll
        for (int kt = 0; kt < 4; ++kt) *(f32x4*)(o + (size_t)(16 * wv + fr) * 64 + 16 * kt + 4 * fq) = ST[kt]; }
    __syncthreads();
#undef RC_ZCOLJ
#undef RC_LANE
#undef RC_PREFETCH
#undef RC_E1
#undef RC_POST
}
template <int KIND>
__device__ __forceinline__ void small_gemm(Frame& F, const bf16* A, int lda, const bf16* Bt, int N, int K, const float* xold, float* ssq_out) {
    const int tid = opaque_tid(F), lane = tid & 63, wv = __builtin_amdgcn_readfirstlane(tid >> 6), fq = lane >> 4, fr = lane & 15;
    LAS float* part = (LAS float*)F.lds;
    const int ntiles = 8 * (N / 64), kw = K / 8, nks = kw / 32;
    const int erow = tid >> 3, ec8 = (tid & 7) * 8;
    for (int tile = F.bid; tile < ntiles; tile += F.G) {
        const int rb = tile & 7, cb = tile >> 3; const int row0 = MP + 64 * rb, col0 = 64 * cb;
        float m8[8];
#pragma unroll
        for (int j = 0; j < 8; ++j) m8[j] = 0.f;
        constexpr int NB_ = (KIND == 1) ? 3 : 1;
#pragma unroll 1
        for (int br = 0; br < NB_; ++br) {
            const bf16* Ab = A + (size_t)(row0 + fr) * lda + wv * kw + 8 * fq + ((KIND == 1) ? (br == 0 ? ZA_G : (br == 1 ? ZB_R : ZC_G)) : 0);
            const bf16* Bb = Bt + (size_t)(KIND == 1 ? br * 1024 : 0) * K + (size_t)(col0 + fr) * K + wv * kw + 8 * fq;
            f32x4 acc[4][4];
#pragma unroll
            for (int m = 0; m < 4; ++m)
#pragma unroll
                for (int n = 0; n < 4; ++n) acc[m][n] = (f32x4){0.f, 0.f, 0.f, 0.f};
            bf16x8 a[4], b[4];
#pragma unroll
            for (int u = 0; u < 4; ++u) { a[u] = *(const bf16x8*)(Ab + (size_t)16 * u * lda); b[u] = *(const bf16x8*)(Bb + (size_t)16 * u * K); }
            for (int ks = 1; ks < nks; ++ks) {
                bf16x8 na[4], nb[4];
#pragma unroll
                for (int u = 0; u < 4; ++u) { na[u] = *(const bf16x8*)(Ab + (size_t)16 * u * lda + 32 * ks); nb[u] = *(const bf16x8*)(Bb + (size_t)16 * u * K + 32 * ks); }
#pragma unroll
                for (int m = 0; m < 4; ++m)
#pragma unroll
                    for (int n = 0; n < 4; ++n) acc[m][n] = __builtin_amdgcn_mfma_f32_16x16x32_bf16(a[m], b[n], acc[m][n], 0, 0, 0);
#pragma unroll
                for (int u = 0; u < 4; ++u) { a[u] = na[u]; b[u] = nb[u]; }
            }
#pragma unroll
            for (int m = 0; m < 4; ++m)
#pragma unroll
                for (int n = 0; n < 4; ++n) acc[m][n] = __builtin_amdgcn_mfma_f32_16x16x32_bf16(a[m], b[n], acc[m][n], 0, 0, 0);
#pragma unroll
            for (int m = 0; m < 4; ++m)
#pragma unroll
                for (int n = 0; n < 4; ++n)
#pragma unroll
                    for (int r = 0; r < 4; ++r) part[wv * 4096 + (16 * m + 4 * fq + r) * 64 + 16 * n + fr] = acc[m][n][r];
            __syncthreads();
            float v[8];
#pragma unroll
            for (int j = 0; j < 8; ++j) v[j] = 0.f;
#pragma unroll
            for (int w = 0; w < 8; ++w) { const f32x4 p0 = *(const LAS f32x4*)(part + w * 4096 + erow * 64 + ec8), p1 = *(const LAS f32x4*)(part + w * 4096 + erow * 64 + ec8 + 4);
                v[0] += p0[0]; v[1] += p0[1]; v[2] += p0[2]; v[3] += p0[3]; v[4] += p1[0]; v[5] += p1[1]; v[6] += p1[2]; v[7] += p1[3]; }
            if (KIND == 1) { const int col = col0 + ec8; const v4u gw = *(const v4u*)(F.Z() + (size_t)(row0 + erow) * NZ + pg8::gate_col(br * 4 + (col >> 8)) + (col & 255));
                m8[0] += bflo(gw.x) * v[0]; m8[1] += bfhi(gw.x) * v[1]; m8[2] += bflo(gw.y) * v[2]; m8[3] += bfhi(gw.y) * v[3];
                m8[4] += bflo(gw.z) * v[4]; m8[5] += bfhi(gw.z) * v[5]; m8[6] += bflo(gw.w) * v[6]; m8[7] += bfhi(gw.w) * v[7]; }
            else {
#pragma unroll
                for (int j = 0; j < 8; ++j) m8[j] = v[j]; }
            __syncthreads();
        }
        const int row = row0 + erow, col = col0 + ec8;
        if (KIND == 0 || KIND == 3) { const float rs = pg8::row_rstd(F.SSQ(), row); float o[8];
#pragma unroll
            for (int j = 0; j < 8; ++j) { float x = m8[j] * rs; if (KIND == 0) x = fsigmoid(x); else { x = fmaxf(x, 0.f); x = x * x; } o[j] = x; }
            v4u w; w.x = pg8::cvt_pk_bf16(o[0], o[1]); w.y = pg8::cvt_pk_bf16(o[2], o[3]); w.z = pg8::cvt_pk_bf16(o[4], o[5]); w.w = pg8::cvt_pk_bf16(o[6], o[7]);
            if (KIND == 0) *(v4u*)(F.Z() + (size_t)row * NZ + pg8::gate_col(col >> 8) + (col & 255)) = w; else *(v4u*)(F.Z() + (size_t)row * DFF + col) = w;
        } else if (KIND == 1) {
            v4u w; w.x = pg8::cvt_pk_bf16(m8[0], m8[1]); w.y = pg8::cvt_pk_bf16(m8[2], m8[3]); w.z = pg8::cvt_pk_bf16(m8[4], m8[5]); w.w = pg8::cvt_pk_bf16(m8[6], m8[7]);
            *(v4u*)(F.Mb() + (size_t)row * D + col) = w;
        } else {
            const f32x4* xo = (const f32x4*)(xold + (size_t)(row - MP) * D + col); const f32x4 x0 = xo[0] + (f32x4){m8[0], m8[1], m8[2], m8[3]}, x1 = xo[1] + (f32x4){m8[4], m8[5], m8[6], m8[7]};
            f32x4* yo = (f32x4*)(F.y_x() + (size_t)row * D + col); yo[0] = x0; yo[1] = x1;
            v4u w; w.x = pg8::cvt_pk_bf16(x0[0], x0[1]); w.y = pg8::cvt_pk_bf16(x0[2], x0[3]); w.z = pg8::cvt_pk_bf16(x1[0], x1[1]); w.w = pg8::cvt_pk_bf16(x1[2], x1[3]);
            *(v4u*)(F.XB() + (size_t)row * D + col) = w;
            float ss = (x0[0] * x0[0] + x0[1] * x0[1]) + (x0[2] * x0[2] + x0[3] * x0[3]) + (x1[0] * x1[0] + x1[1] * x1[1]) + (x1[2] * x1[2] + x1[3] * x1[3]);
            ss = sum8(ss); if ((tid & 7) == 0) ssq_out[(size_t)row * 16 + cb] = ss;
        }
    }
}
struct Args { const float* in[38]; float* out; unsigned char* ws; int ph_lo, ph_hi, omask, pad; };
constexpr int PH_PER_LAYER = 10, PH_FINAL = 2 * PH_PER_LAYER, PH_END = PH_FINAL + 1;
constexpr int CW_BAR = 4096;

__global__ void __launch_bounds__(NTHR, 2) hybrid_fwd(Args args) {
    extern __shared__ __attribute__((aligned(16))) unsigned char lds_raw[];
    Frame F;
    F.lds = (LAS unsigned char*)lds_raw;
    F.tid = threadIdx.x; F.lane = F.tid & 63; F.wave = __builtin_amdgcn_readfirstlane(F.tid >> 6);
    F.G = gridDim.x; F.bid = blockIdx.x; F.omask = args.omask;
    static_assert(offsetof(Args, out) == 304 && offsetof(Args, ws) == 312, "kernarg layout used by LAUNDER");
    { const CAS unsigned char* _kp = (const CAS unsigned char*)__builtin_amdgcn_kernarg_segment_ptr(); F.in = (const float* const CAS*)_kp; F.out = args.out; F.ws = args.ws; }
    unsigned char* ws = args.ws;
    volatile LAS unsigned* MISC = (volatile LAS unsigned*)(F.lds + MISC_OFF);
    if (F.tid < 64) MISC[F.tid] = 0u;
    __syncthreads();
    { const unsigned xcc = xb_xcc_id(); if (threadIdx.x == 0) { (void)xb_add(&((unsigned*)(ws + WS_CTL) + CW_BAR)[XB_XCNT(xcc)], 1u);
        if (F.G <= 64 || F.bid >= 64) (void)xb_add(&((unsigned*)(ws + WS_CTL) + CW_BAR + XCD_BAR_WORDS)[XB_XCNT(xcc)], 1u); } }
    const int lo = args.ph_lo, hi = args.ph_hi;
    const int G = F.G, bid = F.bid;

#define LAUNDER() do { int _t = threadIdx.x; asm volatile("" : "+v"(_t)); F.tid = _t; F.lane = _t & 63; F.wave = __builtin_amdgcn_readfirstlane(_t >> 6); \
        const CAS unsigned char* _kp = (const CAS unsigned char*)__builtin_amdgcn_kernarg_segment_ptr(); asm volatile("" : "+s"(_kp)); \
        F.in = (const float* const CAS*)_kp; F.out = *(float* const CAS*)(_kp + 304); F.ws = *(unsigned char* const CAS*)(_kp + 312); } while (0)
#define MAIN_BAR() do { XcdBarrier _b; _b.bar = (unsigned*)(args.ws + WS_CTL) + CW_BAR; _b.x = xb_xcc_id(); _b.st = (volatile LAS unsigned*)(F.lds + MISC_OFF) + 8; _b.nparts = (unsigned)G; xcd_barrier(_b); } while (0)
#define PHASE_BEGIN(p) if (lo <= (p) && (p) < hi && !((args.omask & 512) && ((p) % 10 >= 2 && (p) % 10 <= 4)) && !((args.omask & 1024) && (p) % 10 == 1)) { if ((p) > lo) MAIN_BAR(); LAUNDER();
#define PHASE_END }
    if (args.omask & (1 << 24)) { for (int i = 0; i < 16; ++i) MAIN_BAR(); }
    for (int l = 0; l < 2; ++l) {
        const int p0 = l * PH_PER_LAYER;
        PHASE_BEGIN(p0 + 0) p0_weights(F, l); if (l == 0) p0_xb(F); PHASE_END
        PHASE_BEGIN(p0 + 1)
            pg8::Gemm g{F.XB(), D, F.WIN(), D}; pg8::Order S; S.init(MROWS, NZ, G, bid, 1, (size_t)256 * D * 2, (size_t)256 * D * 2);
            pg8::EpiRowScale<0> E{F.Z(), NZ, F.SSQ(), F.lds};
            pg8::gemm_phase<pg8::EpiRowScale<0>, pg8::Order, true, true>(F.lds, g, S, E);
        PHASE_END
        PHASE_BEGIN(p0 + 2) p2_misc(F, l); PHASE_END
        PHASE_BEGIN(p0 + 3)
            if (bid < 64 && !(args.omask & 2048)) { const int b = bid >> 3, h = bid & 7;
                rwkv_chain_chunked(F, l, b, h); }
            const bool few = (G <= 64); const bool in_sub = few || bid >= 64; const int me = few ? bid : bid - 64, np = few ? G : G - 64;
            if (in_sub) {
#define SUB_BAR() do { XcdBarrier barB; barB.bar = (unsigned*)(F.ws + WS_CTL) + CW_BAR + XCD_BAR_WORDS; barB.x = xb_xcc_id(); barB.st = (volatile LAS unsigned*)(F.lds + MISC_OFF) + 10; barB.nparts = (unsigned)np; xcd_barrier(barB); LAUNDER(); } while (0)
                const int skip = (args.omask >> 13) & 15; const bool do_items = !(args.omask & 4096), do_p2 = (lo <= p0 + 4 && p0 + 4 < hi && !(args.omask & (1 << 20)));
                constexpr int N_AP = NB * 32 * 4, N_CP = NB * 32, N_CS = 8, N_GS = NSB * 4, N_RS = NSB * 8;
                if (do_items && !(skip & 1)) for (int it = me; it < N_AP; it += np) gdn_prep_unit(F, l, it >> 7, (it >> 2) & 31, it & 3);
                SUB_BAR();
                const int nscan = (np > 64) ? 32 : 0;
                if (me < nscan) { if (do_p2) gdn_scan_unit(F, l, me >> 2, me & 3); }
                else if (do_items) { for (int it = me - nscan; it < N_CP + N_CS + N_GS + N_RS; it += np - nscan) { int r = it;
                    if (r < N_CP) { if (!(skip & 2)) rglru_prep_unit<false>(F, l, r >> 5, r & 31); continue; } r -= N_CP;
                    if (r < N_CS) { if (!(skip & 2)) rglru_prep_unit<true>(F, l, r, 0); continue; } r -= N_CS;
                    if (r < N_GS) { if (!(skip & 4)) gdn_sample_unit(F, l, r >> 2, r & 3); continue; } r -= N_GS;
                    if (!(skip & 8)) { const int sb = r >> 3, h = r & 7;
                      rwkv_unit(F, l, MP + sb * TS, TS, h, F.in[4] + (((size_t)l * NSB + sb) * 8 + h) * 4096, F.in[5] + ((size_t)l * NSB + sb) * 1792, F.s_b_S() + (((size_t)l * NSB + sb) * 8 + h) * 4096); } } }
                if (nscan == 0 && do_p2) for (int it = me; it < 32; it += np) gdn_scan_unit(F, l, it >> 2, it & 3);
                SUB_BAR();
                if (do_p2) for (int it = me; it < NB * 32; it += np) rglru_fix_unit(F, l, it >> 5, it & 31);
#undef SUB_BAR
            }
        PHASE_END
        PHASE_BEGIN(p0 + 5)
            pg8::Gemm g{F.XB(), D, F.WIN() + (size_t)NZ * D, D}; pg8::Order S; S.init(MP, NGATE, G, bid, 1, (size_t)256 * D * 2, (size_t)256 * D * 2);
            pg8::EpiRowScale<1> E{F.Z(), NZ, F.SSQ(), F.lds};
            pg8::gemm_phase<pg8::EpiRowScale<1>, pg8::Order, true, true>(F.lds, g, S, E);
            small_gemm<0>(F, F.XB(), D, F.WIN() + (size_t)NZ * D, NGATE, D, nullptr, nullptr);
        PHASE_END
        PHASE_BEGIN(p0 + 6)
            static_assert(ZA_G * 2 == 3072 && ZB_R * 2 == 4096 && ZC_G * 2 == 8704, "branch A-operand column offsets are hard-wired in pg8::Order::next");
            pg8::Gemm g{F.Z(), NZ, F.WBR(), 512}; pg8::Order S; S.init(MP, D, G, bid, 3, (size_t)256 * NZ * 2, (size_t)256 * 512 * 2);
            pg8::EpiBranch E{F.Mb(), F.Z(), NZ};
            pg8::gemm_phase<pg8::EpiBranch, pg8::Order, true, true>(F.lds, g, S, E);
            small_gemm<1>(F, F.Z(), NZ, F.WBR(), D, 512, nullptr, nullptr);
        PHASE_END
        PHASE_BEGIN(p0 + 7)
            pg8::Gemm g{F.Mb(), D, F.WOUT(), D}; pg8::Order S; S.init(MP, D, G, bid, 1, (size_t)256 * D * 2, (size_t)256 * D * 2);
            pg8::EpiRes E{l == 0 ? F.in[0] : F.y_x(), l == 0 ? F.in[1] : F.y_x() + (size_t)MP * D, F.y_x(), F.XB(), F.SSQ()};
            pg8::gemm_phase<pg8::EpiRes, pg8::Order, true, true>(F.lds, g, S, E);
            small_gemm<2>(F, F.Mb(), D, F.WOUT(), D, D, l == 0 ? F.in[1] : F.y_x() + (size_t)MP * D, F.SSQ());
        PHASE_END
        PHASE_BEGIN(p0 + 8)
            pg8::Gemm g{F.XB(), D, F.WUP(), D}; pg8::Order S; S.init(MP, DFF, G, bid, 1, (size_t)256 * D * 2, (size_t)256 * D * 2);
            pg8::EpiRowScale<2> E{F.Z(), DFF, F.SSQ(), F.lds};
            pg8::gemm_phase<pg8::EpiRowScale<2>, pg8::Order, true, true>(F.lds, g, S, E);
            small_gemm<3>(F, F.XB(), D, F.WUP(), DFF, D, nullptr, nullptr);
        PHASE_END
        PHASE_BEGIN(p0 + 9)
            pg8::Gemm g{F.Z(), DFF, F.WDN(), DFF}; pg8::Order S; S.init(MP, D, G, bid, 1, (size_t)256 * DFF * 2, (size_t)256 * DFF * 2);
            pg8::EpiRes E{F.y_x(), F.y_x() + (size_t)MP * D, F.y_x(), F.XB(), F.SSQ()};
            pg8::gemm_phase<pg8::EpiRes, pg8::Order, true, true>(F.lds, g, S, E);
            small_gemm<2>(F, F.Z(), DFF, F.WDN(), D, DFF, F.y_x() + (size_t)MP * D, F.SSQ());
        PHASE_END
    }
    if (args.omask & 256) { MAIN_BAR(); LAUNDER();
        const int c0 = args.omask >> 16; const int gw = bid * NWAVES + F.wave, NGW = G * NWAVES;
        for (int m = gw; m < MROWS; m += NGW) { const bf16* src = (c0 == 9999) ? F.Mb() + (size_t)m * D : F.Z() + (size_t)m * NZ + c0; float* dst = F.y_x() + (size_t)m * D;
            for (int j = F.lane; j < D / 2; j += 64) { const unsigned w = ((const unsigned*)src)[j]; dst[2 * j] = bflo(w); dst[2 * j + 1] = bfhi(w); } }
    }
    if ((lo <= PH_FINAL && PH_FINAL < hi) || (args.omask & 128)) { MAIN_BAR(); LAUNDER();
        const float* fg = F.in[37]; const int gw = bid * NWAVES + F.wave, NGW = G * NWAVES;
        for (int m = gw; m < MROWS; m += NGW) { f32x4* xp = (f32x4*)(F.y_x() + (size_t)m * D) + F.lane * 4; f32x4 v[4]; float s = 0.f;
#pragma unroll
            for (int j = 0; j < 4; ++j) { v[j] = xp[j]; s += (v[j][0] * v[j][0] + v[j][1] * v[j][1]) + (v[j][2] * v[j][2] + v[j][3] * v[j][3]); }
            const float rs = __builtin_amdgcn_rsqf(wave_sum(s) * (1.f / D) + EPS);
#pragma unroll
            for (int j = 0; j < 4; ++j) { const f32x4 gg = ((const f32x4*)fg)[F.lane * 4 + j]; xp[j] = v[j] * rs * gg; } }
    PHASE_END
#undef LAUNDER
#undef MAIN_BAR
#undef PHASE_BEGIN
#undef PHASE_END
}

static int fast_launch(void* const* d_in, void* d_out, void* d_ws, size_t ws_size, hipStream_t stream, int ph_lo, int ph_hi, int omask) {
    static int grid = 0;
    if (grid == 0) {
        if (ws_size < WS_END) { fprintf(stderr, "kernel_launch: needs %zu bytes of workspace, got %zu\n", (size_t)WS_END, ws_size); grid = -1; return -1; }
        int dev = 0, cus = 0, per_cu = 0;
        if (hipGetDevice(&dev) != hipSuccess || hipDeviceGetAttribute(&cus, hipDeviceAttributeMultiprocessorCount, dev) != hipSuccess) { grid = -1; return -1; }
        if (hipFuncSetAttribute((const void*)hybrid_fwd, hipFuncAttributeMaxDynamicSharedMemorySize, LDS_BYTES) != hipSuccess) { fprintf(stderr, "kernel_launch: hipFuncSetAttribute failed\n"); grid = -1; return -1; }
        if (hipOccupancyMaxActiveBlocksPerMultiprocessor(&per_cu, (const void*)hybrid_fwd, NTHR, LDS_BYTES) != hipSuccess || per_cu < 1) fprintf(stderr, "kernel_launch: occupancy query says %d blocks per CU\n", per_cu);
        (void)hipGetLastError();
        grid = cus;
        fprintf(stderr, "kernel_launch: grid %d, ws %zu\n", grid, ws_size);
    }
    if (grid < 0) return -1;
    if (hipMemsetAsync((char*)d_ws + WS_CTL, 0, CTL_ZERO_BYTES, stream) != hipSuccess) return -1;
    Args a{};
    for (int i = 0; i < 38; ++i) a.in[i] = (const float*)d_in[i];
    a.out = (float*)d_out; a.ws = (unsigned char*)d_ws; a.ph_lo = ph_lo; a.ph_hi = ph_hi; a.omask = omask; a.pad = 0;
    hipLaunchKernelGGL(hybrid_fwd, dim3(grid), dim3(NTHR), LDS_BYTES, stream, a);
    return 0;
}
extern "C" void kernel_launch(void* const* d_in, const int* in_sizes, int n_in, void* d_out, int out_size, void* d_ws, size_t ws_size, hipStream_t stream) {
    fast_launch(d_in, d_out, d_ws, ws_size, stream, 0, 21, 127);
}
```

```cpp
#include <hip/hip_runtime.h>
#include <cstdio>
#include <cstdint>
#include <cstddef>
#define GAS __attribute__((address_space(1)))
#define LAS __attribute__((address_space(3)))
#define CAS __attribute__((address_space(4)))
typedef unsigned short bf16;
typedef unsigned v4u __attribute__((ext_vector_type(4)));
typedef unsigned v2u __attribute__((ext_vector_type(2)));
typedef float f32x4 __attribute__((ext_vector_type(4)));
typedef float f32x2 __attribute__((ext_vector_type(2)));
typedef short bf16x8 __attribute__((ext_vector_type(8)));
typedef short bf16x4 __attribute__((ext_vector_type(4)));

constexpr int NWAVES = 8, NTHR = 512;
constexpr int D = 1024, DFF = 4096, MP = 16384, MS = 512, MROWS = MP + MS;
constexpr int SEQ = 2048, NB = 8, NSB = 128, TS = 4;
constexpr int NIN_SRC = 7944;
constexpr int NZ = 4864;
constexpr int ZA_Q = 0, ZA_K = 512, ZA_V = 1024, ZA_G = 1536, ZB_R = 2048, ZB_K = 2560, ZB_V = 3072, ZB_XW = 3584, ZB_XA = 3648, ZB_XG = 3712, ZC_X = 3840, ZC_G = 4352;
constexpr int NGATE = 3072, NWIN = NZ + NGATE;
constexpr float EPS = 1e-6f, B_LN_EPS = 64e-5f;

constexpr size_t MiB = 1u << 20;
constexpr size_t WS_CTL = 0, CTL_ZERO_BYTES = 1 * MiB;
constexpr size_t WS_WIN = 1 * MiB, WS_WBR = 17 * MiB, WS_WOUT = 20 * MiB, WS_WUP = 22 * MiB, WS_WDN = 30 * MiB, WS_MISCW = 38 * MiB;
constexpr size_t WS_XB = 39 * MiB, WS_SSQ = 72 * MiB, WS_BG = 74 * MiB, WS_HALO = 75 * MiB, WS_CSUM = 79 * MiB, WS_GL = 80 * MiB, WS_GW = 81 * MiB, WS_GATT = 97 * MiB;
constexpr size_t WS_M = 105 * MiB, WS_Z = 138 * MiB, WS_END = 295 * MiB;
static_assert(WS_Z + (size_t)MROWS * NZ * 2 <= WS_END && (size_t)MROWS * DFF * 2 <= (size_t)MROWS * NZ * 2, "ws map");
constexpr size_t MW_WSP = 0;
constexpr size_t MW_WCA = 64 * 1024;
constexpr size_t MW_WCX = 128 * 1024;
constexpr size_t HALO_A_OFF = 0;
constexpr size_t HALO_C_OFF = 3 * MiB;

constexpr int LDS_BYTES = 163840;
constexpr int MISC_OFF = LDS_BYTES - 256;

#define RLX_AGENT __ATOMIC_RELAXED, __HIP_MEMORY_SCOPE_AGENT
#define LDS_WAIT() asm volatile("s_waitcnt lgkmcnt(0)" ::: "memory")
#define VM_WAIT() asm volatile("s_waitcnt vmcnt(0)" ::: "memory")

typedef __bf16 bf16x2_t __attribute__((ext_vector_type(2)));
__device__ __forceinline__ unsigned pk2(float lo, float hi) { const f32x2 v = {lo, hi}; return __builtin_bit_cast(unsigned, __builtin_convertvector(v, bf16x2_t)); }
__device__ __forceinline__ unsigned f2bf(float f) { return pk2(f, 0.f) & 0xffffu; }
__device__ __forceinline__ float bf2f(unsigned short b) { return __builtin_bit_cast(float, ((unsigned)b) << 16); }
__device__ __forceinline__ float bflo(unsigned w) { return __builtin_bit_cast(float, w << 16); }
__device__ __forceinline__ float bfhi(unsigned w) { return __builtin_bit_cast(float, w & 0xffff0000u); }
__device__ __forceinline__ float fexp(float x) { return __expf(x); }
__device__ __forceinline__ float fsigmoid(float x) { return __builtin_amdgcn_rcpf(1.f + __expf(-x)); }
__device__ __forceinline__ float fsoftplus(float x) { return fmaxf(x, 0.f) + __logf(1.f + __expf(-fabsf(x))); }
__device__ __forceinline__ float fsilu(float x) { return x * fsigmoid(x); }
__device__ __forceinline__ float ftanh(float x) { const float e = __expf(2.f * x); return 1.f - 2.f * __builtin_amdgcn_rcpf(e + 1.f); }
__device__ __forceinline__ float fgelu(float x) { return 0.5f * x * (1.f + ftanh(0.7978845608028654f * (x + 0.044715f * x * x * x))); }
template <int CTRL> __device__ __forceinline__ float dppf(float x) { return __builtin_bit_cast(float, __builtin_amdgcn_mov_dpp(__builtin_bit_cast(int, x), CTRL, 0xf, 0xf, true)); }
__device__ __forceinline__ float sum8(float x) {
    x += dppf<0xB1>(x); x += dppf<0x4E>(x); x += dppf<0x141>(x); return x; }
__device__ __forceinline__ float sum16(float x) {
    x += dppf<0xB1>(x); x += dppf<0x4E>(x); x += dppf<0x141>(x); x += dppf<0x140>(x); return x; }
__device__ __forceinline__ float xor16f(float x) { return __builtin_bit_cast(float, __builtin_amdgcn_ds_swizzle(__builtin_bit_cast(int, x), 0x401F)); }
__device__ __forceinline__ float add_xor32(float x) {
    const auto r = __builtin_amdgcn_permlane32_swap(__builtin_bit_cast(unsigned, x), __builtin_bit_cast(unsigned, x), false, false);
    return __builtin_bit_cast(float, (unsigned)r[0]) + __builtin_bit_cast(float, (unsigned)r[1]); }
__device__ __forceinline__ float wave_sum(float v) { v = sum16(v); v += xor16f(v); return add_xor32(v); }
namespace pg8 {
#define PG8_LAS __attribute__((address_space(3)))
typedef unsigned short bf16_t;
constexpr int BM = 256, BK = 64, HALF = 128, HTB = HALF * BK * 2, STAGE_BYTES = 8 * HTB, NXCD = 8, WGM = 8;

__host__ __device__ __forceinline__ int lds_byte(int r, int c) { const int st = (r >> 4) * 2 + (c >> 5), rr = r & 15, cc = c & 31, ob = rr * 64 + cc * 2; return st * 1024 + (ob ^ (((ob >> 9) & 1) << 5)); }
__host__ __device__ __forceinline__ void stage_rc(int b, int& R, int& C) { const int st = b / 1024, sb = b % 1024, swz = sb ^ (((sb >> 9) & 1) << 5); R = (st >> 1) * 16 + swz / 64; C = (st & 1) * 32 + (swz % 64) / 2; }
__host__ __device__ __forceinline__ int perm32(int rho) { const int n = rho >> 4, i = rho & 15; return 8 * (i >> 2) + 4 * n + (i & 3); }

struct Unit { int pm, pn, aux; size_t a_off, b_off; };
struct Gemm { const bf16_t* A; int lda; const bf16_t* Bt; int K; };

struct Order {
    int nM, nN, nwg, G, c, rep;
    size_t a_tile, b_tile;
    __device__ __forceinline__ void init(int M, int N, int G_, int c_, int rep_, size_t a_tile_, size_t b_tile_) {
        nM = M / BM; nN = N / BM; nwg = nM * nN; G = G_; c = c_; rep = rep_; a_tile = a_tile_; b_tile = b_tile_;
        }
    __device__ __forceinline__ bool next(int i, Unit& u) const {
        int t = i, sub = i; if (rep == 3) { t = i / 3; sub = i - 3 * t; }
        const long L = (long)t * G + c; if (L >= nwg) return false;
        int wgid = (int)L; { const int q = nwg / NXCD, r = nwg % NXCD, xcd = wgid % NXCD, off = wgid / NXCD; wgid = (xcd < r ? xcd * (q + 1) : r * (q + 1) + (xcd - r) * q) + off; }
        const int nig = WGM * nN, gid = wgid / nig, fm = gid * WGM, gsz = (nM - fm) < WGM ? (nM - fm) : WGM;
        u.pm = fm + ((wgid % nig) % gsz); u.pn = (wgid % nig) / gsz; u.aux = sub;
        u.a_off = (size_t)u.pm * a_tile; u.b_off = (size_t)u.pn * b_tile;
        if (rep == 3) {
            u.a_off += (size_t)(3072 + 1024 * sub + (sub >> 1) * 3584); u.b_off += (size_t)sub * (1024 * 512 * 2); }
        return true;
    }
    __device__ __forceinline__ void a_ready(const Unit&) const {}
    __device__ __forceinline__ void done(const Unit&) const {}
};

__device__ __forceinline__ int gate_col(int t) { return t < 4 ? 256 * t : (t < 8 ? 2560 + 256 * (t - 4) : (t < 10 ? 1024 + 256 * (t - 8) : 3840 + 256 * (t - 10))); }
__device__ __forceinline__ unsigned cvt_pk_bf16(float lo, float hi) { const f32x2 v = {lo, hi}; return __builtin_bit_cast(unsigned, __builtin_convertvector(v, bf16x2_t)); }

__device__ __forceinline__ float row_rstd(const float* ssq, int row) {
    const f32x4* p = (const f32x4*)(ssq + (size_t)row * 16); const f32x4 a = p[0], b = p[1], c = p[2], d = p[3];
    const float s = ((a[0] + a[1]) + (a[2] + a[3])) + ((b[0] + b[1]) + (b[2] + b[3])) + ((c[0] + c[1]) + (c[2] + c[3])) + ((d[0] + d[1]) + (d[2] + d[3]));
    return __builtin_amdgcn_rsqf(s * (1.0f / 1024.0f) + 1e-6f);
}
template <int ACT> struct EpiRowScale {
    static constexpr bool PERM = true, AFTER_DRAIN = false, PREP = true;
    bf16_t* O; int ldc; const float* ssq;
    template <class Sched> __device__ __forceinline__ void prepare(PG8_LAS unsigned char* lds, const Sched& S, int tid) const {
        PG8_LAS float* tab = (PG8_LAS float*)(lds + STAGE_BYTES); Unit u;
        for (int i = 0; i < 8 && S.next(i, u); ++i) if (tid < 256) tab[i * 256 + tid] = row_rstd(ssq, u.pm * BM + tid);
        __syncthreads();
    }
    PG8_LAS unsigned char* ldsE;
    __device__ __forceinline__ void operator()(const f32x4 (&acc)[2][2][4][2], const Unit& u, int wr, int wc, int fr, int fq) const {
        const int row0 = u.pm * BM + wr * 64 + fr;
        int colt = u.pn * BM; if (ACT == 1) colt = gate_col(u.pn);
        const int col0 = colt + wc * 32 + 8 * fq;
#pragma unroll
        for (int ai = 0; ai < 2; ++ai)
#pragma unroll
            for (int m = 0; m < 4; ++m) { const int row = row0 + ai * HALF + m * 16; const float rs = ((const PG8_LAS float*)(ldsE + STAGE_BYTES))[u.aux * 256 + (row & 255)];
                bf16_t* rowp = O + (size_t)row * ldc + col0;
#pragma unroll
                for (int bj = 0; bj < 2; ++bj) { f32x4 v0 = acc[ai][bj][m][0] * rs, v1 = acc[ai][bj][m][1] * rs;
                    if (ACT == 1) {
#pragma unroll
                        for (int j = 0; j < 4; ++j) { v0[j] = __builtin_amdgcn_rcpf(1.f + __expf(-v0[j])); v1[j] = __builtin_amdgcn_rcpf(1.f + __expf(-v1[j])); } }
                    if (ACT == 2) {
#pragma unroll
                        for (int j = 0; j < 4; ++j) { const float a = fmaxf(v0[j], 0.f), b = fmaxf(v1[j], 0.f); v0[j] = a * a; v1[j] = b * b; } }
                    v4u w; w.x = cvt_pk_bf16(v0[0], v0[1]); w.y = cvt_pk_bf16(v0[2], v0[3]); w.z = cvt_pk_bf16(v1[0], v1[1]); w.w = cvt_pk_bf16(v1[2], v1[3]);
                    *(v4u*)(rowp + bj * HALF) = w; } }
    }
};
struct EpiBranch {
    static constexpr bool PERM = true, AFTER_DRAIN = false, PREP = false;
    bf16_t* Mb; const bf16_t* Zg; int ldz;
    __device__ __forceinline__ void operator()(const f32x4 (&acc)[2][2][4][2], const Unit& u, int wr, int wc, int fr, int fq) const {
        const int row0 = u.pm * BM + wr * 64 + fr; const int b = u.aux;
        const int col0 = u.pn * BM + wc * 32 + 8 * fq, g0 = gate_col(b * 4 + u.pn) + wc * 32 + 8 * fq;
#pragma unroll
        for (int ai = 0; ai < 2; ++ai)
#pragma unroll
            for (int m = 0; m < 4; ++m) { const int row = row0 + ai * HALF + m * 16;
                bf16_t* mp = Mb + (size_t)row * 1024 + col0; const bf16_t* gp = Zg + (size_t)row * ldz + g0;
                v4u gw2[2], ow2[2];
#pragma unroll
                for (int bj = 0; bj < 2; ++bj) { gw2[bj] = *(const v4u*)(gp + bj * HALF); if (b != 0) ow2[bj] = *(const v4u*)(mp + bj * HALF); }
#pragma unroll
                for (int bj = 0; bj < 2; ++bj) { const v4u gw = gw2[bj];
                    f32x4 v0 = acc[ai][bj][m][0], v1 = acc[ai][bj][m][1];
                    v0[0] *= bflo(gw.x); v0[1] *= bfhi(gw.x); v0[2] *= bflo(gw.y); v0[3] *= bfhi(gw.y);
                    v1[0] *= bflo(gw.z); v1[1] *= bfhi(gw.z); v1[2] *= bflo(gw.w); v1[3] *= bfhi(gw.w);
                    if (b != 0) { const v4u ow = ow2[bj];
                        v0[0] += bflo(ow.x); v0[1] += bfhi(ow.x); v0[2] += bflo(ow.y); v0[3] += bfhi(ow.y);
                        v1[0] += bflo(ow.z); v1[1] += bfhi(ow.z); v1[2] += bflo(ow.w); v1[3] += bfhi(ow.w); }
                    v4u w; w.x = cvt_pk_bf16(v0[0], v0[1]); w.y = cvt_pk_bf16(v0[2], v0[3]); w.z = cvt_pk_bf16(v1[0], v1[1]); w.w = cvt_pk_bf16(v1[2], v1[3]);
                    *(v4u*)(mp + bj * HALF) = w; }
                if (m & 1) asm volatile("" ::: "memory"); }
    }
};
struct EpiRes {
    static constexpr bool PERM = false, AFTER_DRAIN = false, PREP = false;
    const float* xp; const float* xs; float* out; bf16_t* xb; float* ssq;
    __device__ __forceinline__ void operator()(const f32x4 (&acc)[2][2][4][2], const Unit& u, int wr, int wc, int fr, int fq) const {
        const int row0 = u.pm * BM + wr * 64 + fr, col0 = u.pn * BM + wc * 32 + 4 * fq;
        const float* base = (u.pm < 64) ? xp + (size_t)row0 * 1024 : xs + (size_t)(row0 - 16384) * 1024;
#pragma unroll
        for (int ai = 0; ai < 2; ++ai)
#pragma unroll
            for (int m = 0; m < 4; ++m) { const size_t roff = (size_t)(ai * HALF + m * 16) * 1024 + col0; const int row = row0 + ai * HALF + m * 16;
                float ss = 0.f;
#pragma unroll
                for (int bj = 0; bj < 2; ++bj)
#pragma unroll
                    for (int n = 0; n < 2; ++n) { const f32x4 bs = *(const f32x4*)(base + roff + bj * HALF + n * 16); const f32x4 o = bs + acc[ai][bj][m][n];
                        *(f32x4*)(out + (size_t)row * 1024 + col0 + bj * HALF + n * 16) = o;
                        v2u w; w.x = cvt_pk_bf16(o[0], o[1]); w.y = cvt_pk_bf16(o[2], o[3]);
                        *(v2u*)(xb + (size_t)row * 1024 + col0 + bj * HALF + n * 16) = w;
                        ss += (o[0] * o[0] + o[1] * o[1]) + (o[2] * o[2] + o[3] * o[3]); }
                ss += xor16f(ss); ss = add_xor32(ss);
                if (fq == 0) ssq[(size_t)row * 16 + u.pn * 4 + wc] = ss;
                asm volatile("" ::: "memory"); }
    }
};

template <class Epi, class Sched, bool ALIGN_EPI = false, bool SP2 = false>
__device__ __forceinline__ void gemm_phase(PG8_LAS unsigned char* lds, const Gemm g, const Sched& S, const Epi& E) {
    int tid = threadIdx.x; asm volatile("" : "+v"(tid));
    const int wid = __builtin_amdgcn_readfirstlane(tid >> 6), lane = tid & 63, wr = wid >> 2, wc = wid & 3, fr = lane & 15, fq = lane >> 4;
    const int K = g.K, nt = K / BK, lda = g.lda;
    unsigned voffA[2], voffB[2];
#pragma unroll
    for (int i = 0; i < 2; ++i) { int R, C; stage_rc(tid * 16 + i * 8192, R, C); const int Rb = Epi::PERM ? ((R & ~31) + perm32(R & 31)) : R;
        voffA[i] = (unsigned)(R * lda + C) * 2u; voffB[i] = (unsigned)(Rb * K + C) * 2u; }
    const size_t kstep = (size_t)(BK * 2);
    const size_t hstepA = (size_t)HALF * lda * 2, hstepB = (size_t)HALF * K * 2;
    const unsigned ldsw = (unsigned)wid * 1024u;
    const int aoff = lds_byte(wr * 64 + fr, fq * 8), boff = lds_byte(wc * 32 + fr, fq * 8);
#define PG8_SA(b, h) (((b) * 2 + (h)) * HTB)
#define PG8_SB(b, h) ((4 + (b) * 2 + (h)) * HTB)
#define PG8_STAGE(bufoff, gbase, voff) do { _Pragma("unroll") for (int _i = 0; _i < 2; ++_i) \
        __builtin_amdgcn_global_load_lds((const unsigned*)((const char*)(gbase) + (voff)[_i]), (PG8_LAS unsigned*)(lds + (bufoff) + ldsw + _i * 8192), 16, 0, 0); } while (0)
#define PG8_LDA(dst, b, h) do { _Pragma("unroll") for (int m = 0; m < 4; ++m) _Pragma("unroll") for (int k = 0; k < 2; ++k) dst[m][k] = *(const PG8_LAS bf16x8*)(lds + PG8_SA(b, h) + aoff + m * 2048 + k * 1024); } while (0)
#define PG8_LDB(dst, b, h) do { _Pragma("unroll") for (int n = 0; n < 2; ++n) _Pragma("unroll") for (int k = 0; k < 2; ++k) dst[n][k] = *(const PG8_LAS bf16x8*)(lds + PG8_SB(b, h) + boff + n * 2048 + k * 1024); } while (0)
#define PG8_MMA(ai, bj, At, Bt) do { __builtin_amdgcn_s_setprio(1); _Pragma("unroll") for (int m = 0; m < 4; ++m) _Pragma("unroll") for (int n = 0; n < 2; ++n) _Pragma("unroll") for (int k = 0; k < 2; ++k) \
        acc[ai][bj][m][n] = __builtin_amdgcn_mfma_f32_16x16x32_bf16(Bt[n][k], At[m][k], acc[ai][bj][m][n], 0, 0, 0); __builtin_amdgcn_s_setprio(0); } while (0)
#define PG8_WAIT_V(n) asm volatile("s_waitcnt vmcnt(" #n ")" ::: "memory")
#define PG8_WAIT_L(n) asm volatile("s_waitcnt lgkmcnt(" #n ")" ::: "memory")
#define PG8_BAR __builtin_amdgcn_s_barrier()
#define PG8_SCHED __builtin_amdgcn_sched_barrier(0)
    if constexpr (Epi::PREP) E.prepare(lds, S, tid);
    Unit cur, nxt; int ui = 0;
    if (!S.next(0, cur)) return;
    f32x4 acc[2][2][4][2];
#pragma unroll
    for (int a = 0; a < 2; ++a)
#pragma unroll
        for (int b = 0; b < 2; ++b)
#pragma unroll
            for (int m = 0; m < 4; ++m)
#pragma unroll
                for (int n = 0; n < 2; ++n) acc[a][b][m][n] = (f32x4){0.f, 0.f, 0.f, 0.f};
    bf16x8 At[4][2], B0[2][2], B1[2][2];
    const char* cA = (const char*)g.A + cur.a_off; const char* cB = (const char*)g.Bt + cur.b_off;
    S.a_ready(cur);
    if constexpr (SP2) {
        PG8_STAGE(PG8_SB(0, 0), cB, voffB); PG8_STAGE(PG8_SB(0, 1), cB + hstepB, voffB); PG8_STAGE(PG8_SA(0, 0), cA, voffA); PG8_STAGE(PG8_SA(0, 1), cA + hstepA, voffA);
        if (wr == 1) PG8_BAR;
        PG8_WAIT_V(2); PG8_BAR;
        PG8_STAGE(PG8_SB(1, 0), cB + kstep, voffB); PG8_STAGE(PG8_SA(1, 0), cA + kstep, voffA); PG8_STAGE(PG8_SB(1, 1), cB + hstepB + kstep, voffB);
        PG8_WAIT_V(6); PG8_BAR;
    } else {
        PG8_STAGE(PG8_SB(0, 0), cB, voffB); PG8_STAGE(PG8_SA(0, 0), cA, voffA); PG8_STAGE(PG8_SB(0, 1), cB + hstepB, voffB); PG8_STAGE(PG8_SA(0, 1), cA + hstepA, voffA);
        if (wr == 1) PG8_BAR;
        PG8_WAIT_V(4); PG8_BAR;
        PG8_STAGE(PG8_SB(1, 0), cB + kstep, voffB); PG8_STAGE(PG8_SA(1, 0), cA + kstep, voffA); PG8_STAGE(PG8_SB(1, 1), cB + hstepB + kstep, voffB);
        PG8_WAIT_V(6); PG8_BAR;
    }
    for (;;) {
        const bool has_next = S.next(ui + 1, nxt);
        const char* nA = has_next ? (const char*)g.A + nxt.a_off : cA; const char* nB = has_next ? (const char*)g.Bt + nxt.b_off : cB;
        for (int t = 0; t < nt; t += 2) {
            const bool last = (t == nt - 2);
            const char* a1 = cA + (size_t)(t + 1) * kstep;
            const char* a2 = last ? nA : cA + (size_t)(t + 2) * kstep; const char* b2 = last ? nB : cB + (size_t)(t + 2) * kstep;
            const char* a3 = a2 + kstep; const char* b3 = b2 + kstep;
            if (last && has_next) S.a_ready(nxt);
            if constexpr (SP2) {
            PG8_LDB(B0, 0, 0); PG8_LDB(B1, 0, 1); PG8_SCHED; PG8_LDA(At, 0, 0); PG8_STAGE(PG8_SA(1, 1), a1 + hstepA, voffA);
            PG8_WAIT_V(8); PG8_WAIT_L(0); PG8_BAR; PG8_MMA(0, 0, At, B0); PG8_MMA(0, 1, At, B1); PG8_BAR; PG8_SCHED;
            PG8_LDA(At, 0, 1); PG8_STAGE(PG8_SB(0, 0), b2, voffB); PG8_STAGE(PG8_SB(0, 1), b2 + hstepB, voffB); PG8_STAGE(PG8_SA(0, 0), a2, voffA);
            PG8_WAIT_V(8); PG8_WAIT_L(0); PG8_BAR; PG8_MMA(1, 0, At, B0); PG8_MMA(1, 1, At, B1); PG8_BAR; PG8_SCHED;
            PG8_LDB(B0, 1, 0); PG8_LDB(B1, 1, 1); PG8_SCHED; PG8_LDA(At, 1, 0); PG8_STAGE(PG8_SA(0, 1), a2 + hstepA, voffA);
            PG8_WAIT_V(8); PG8_WAIT_L(0); PG8_BAR; PG8_MMA(0, 0, At, B0); PG8_MMA(0, 1, At, B1); PG8_BAR; PG8_SCHED;
            PG8_LDA(At, 1, 1); PG8_STAGE(PG8_SB(1, 0), b3, voffB); PG8_STAGE(PG8_SB(1, 1), b3 + hstepB, voffB); PG8_STAGE(PG8_SA(1, 0), a3, voffA);
            PG8_WAIT_V(8); PG8_WAIT_L(0); PG8_BAR; PG8_MMA(1, 0, At, B0); PG8_MMA(1, 1, At, B1); PG8_BAR; PG8_SCHED;
            } else {
            PG8_LDB(B0, 0, 0); PG8_SCHED; PG8_LDA(At, 0, 0); PG8_STAGE(PG8_SA(1, 1), a1 + hstepA, voffA);
            PG8_WAIT_L(8); PG8_BAR; PG8_WAIT_L(0); PG8_MMA(0, 0, At, B0); PG8_BAR; PG8_SCHED;
            PG8_LDB(B1, 0, 1); PG8_STAGE(PG8_SB(0, 0), b2, voffB);
            PG8_BAR; PG8_WAIT_L(0); PG8_MMA(0, 1, At, B1); PG8_BAR;
            PG8_LDA(At, 0, 1); PG8_STAGE(PG8_SA(0, 0), a2, voffA);
            PG8_BAR; PG8_WAIT_L(0); PG8_MMA(1, 0, At, B0); PG8_BAR; PG8_SCHED;
            PG8_STAGE(PG8_SB(0, 1), b2 + hstepB, voffB);
            PG8_WAIT_V(6); PG8_BAR; PG8_MMA(1, 1, At, B1); PG8_BAR;
            PG8_LDB(B0, 1, 0); PG8_SCHED; PG8_LDA(At, 1, 0); PG8_STAGE(PG8_SA(0, 1), a2 + hstepA, voffA);
            PG8_WAIT_L(8); PG8_BAR; PG8_WAIT_L(0); PG8_MMA(0, 0, At, B0); PG8_BAR; PG8_SCHED;
            PG8_LDB(B1, 1, 1); PG8_STAGE(PG8_SB(1, 0), b3, voffB);
            PG8_BAR; PG8_WAIT_L(0); PG8_MMA(0, 1, At, B1); PG8_BAR;
            PG8_LDA(At, 1, 1); PG8_STAGE(PG8_SA(1, 0), a3, voffA);
            PG8_BAR; PG8_WAIT_L(0); PG8_MMA(1, 0, At, B0); PG8_BAR; PG8_SCHED;
            PG8_STAGE(PG8_SB(1, 1), b3 + hstepB, voffB);
            PG8_WAIT_V(6); PG8_BAR; PG8_MMA(1, 1, At, B1); PG8_BAR;
            }
        }
        if constexpr (ALIGN_EPI) { if (wr == 0) PG8_BAR; }
        if constexpr (!Epi::AFTER_DRAIN) { E(acc, cur, wr, wc, fr, fq); S.done(cur); }
        if (!has_next) break;
#pragma unroll
        for (int a = 0; a < 2; ++a)
#pragma unroll
            for (int b = 0; b < 2; ++b)
#pragma unroll
                for (int m = 0; m < 4; ++m)
#pragma unroll
                    for (int n = 0; n < 2; ++n) acc[a][b][m][n] = (f32x4){0.f, 0.f, 0.f, 0.f};
        cur = nxt; cA = nA; cB = nB; ++ui;
        if constexpr (ALIGN_EPI) { if (wr == 1) PG8_BAR; }
    }
    PG8_WAIT_V(0);
    if constexpr (!ALIGN_EPI) { if (wr == 0) PG8_BAR; }
    PG8_BAR;
#undef PG8_SA
#undef PG8_SB
#undef PG8_STAGE
#undef PG8_LDA
#undef PG8_LDB
#undef PG8_MMA
#undef PG8_WAIT_V
#undef PG8_WAIT_L
#undef PG8_BAR
#undef PG8_SCHED
}
}
typedef GAS unsigned gu32;
#define XB_TMO      128
#define XB_XCNT(j)  (256  + 64 * (j))
#define XB_XSUB(j)  (1280 + 64 * (j))
#define XB_XGEN(j)  (2304 + 64 * (j))
#define XB_TOP      3328
#define XB_TOPGEN   3392
#define XCD_BAR_WORDS 3456
#define XB_SPIN_CAP (1u << 20)

__device__ __forceinline__ unsigned xb_ld(unsigned* p)              { return __hip_atomic_load(p, __ATOMIC_RELAXED, __HIP_MEMORY_SCOPE_AGENT); }
__device__ __forceinline__ unsigned xb_add(unsigned* p, unsigned v) { return __hip_atomic_fetch_add(p, v, __ATOMIC_RELAXED, __HIP_MEMORY_SCOPE_AGENT); }
__device__ __forceinline__ unsigned xb_xcc_id() { return (unsigned)__builtin_amdgcn_s_getreg((3 << 11) | 20) & 0xFu; }
#define XB_SPIN(cond, bar) do { unsigned _sp = 0; while (cond) { __builtin_amdgcn_s_sleep(1); \
    if ((++_sp & 255u) == 0u) { if (xb_ld(&(bar)[XB_TMO])) break; if (_sp > XB_SPIN_CAP) { atomicAdd(&(bar)[XB_TMO], 1u); break; } } } } while (0)

struct XcdBarrier {
    unsigned* bar; unsigned x; unsigned nparts;
    volatile LAS unsigned* st;
};
__device__ __forceinline__ XcdBarrier xcd_barrier_post(unsigned* bar, volatile LAS unsigned* st, unsigned nparts) {
    XcdBarrier b; b.bar = bar; b.x = xb_xcc_id(); b.st = st; b.nparts = nparts;
    if (threadIdx.x == 0) (void)xb_add(&bar[XB_XCNT(b.x)], 1u);
    return b;
}
__device__ __forceinline__ void xcd_barrier_complete(unsigned* bar, unsigned x, unsigned G, unsigned& nloc, unsigned& nx) {
    unsigned sum, cnt, mine, sp = 0u;
    for (;;) {
        sum = 0u; cnt = 0u; mine = 0u;
#pragma unroll
        for (unsigned j = 0; j < 16; ++j) { const unsigned c = xb_ld(&bar[XB_XCNT(j)]); sum += c; cnt += (c > 0u) ? 1u : 0u; mine = (j == x) ? c : mine; }
        if (sum == G) break;
        __builtin_amdgcn_s_sleep(1);
        if ((++sp & 255u) == 0u) { if (xb_ld(&bar[XB_TMO])) break; if (sp > XB_SPIN_CAP) { atomicAdd(&bar[XB_TMO], 1u); break; } }
    }
    nloc = mine > 0u ? mine : 1u; nx = cnt > 0u ? cnt : 1u;
}
__device__ __forceinline__ void xcd_barrier(const XcdBarrier& b0) {
    asm volatile("s_waitcnt vmcnt(0)" ::: "memory");
    __syncthreads();
    if (threadIdx.x == 0) {
        XcdBarrier b = b0; { unsigned* p = b.bar; unsigned x = b.x; asm volatile("" : "+s"(p), "+s"(x)); b.bar = p; b.x = x; }
        unsigned* bar = b.bar;
        __builtin_amdgcn_s_waitcnt(0);
        unsigned nloc = b.st[0], nx = b.st[1];
        if (nloc == 0u) { xcd_barrier_complete(bar, b.x, b.nparts, nloc, nx); b.st[0] = nloc; b.st[1] = nx; }
        const unsigned old = xb_add(&bar[XB_XSUB(b.x)], 1u);
        const unsigned gen = old / nloc;
        if (old + 1u == (gen + 1u) * nloc) {
            __builtin_amdgcn_fence(__ATOMIC_RELEASE, "agent");
            asm volatile("s_waitcnt vmcnt(0)" ::: "memory");
            const unsigned og = xb_add(&bar[XB_TOP], 1u);
            const unsigned tg = og / nx;
            if (og + 1u == (tg + 1u) * nx) xb_add(&bar[XB_TOPGEN], 1u);
            else XB_SPIN(xb_ld(&bar[XB_TOPGEN]) == tg, bar);
            __builtin_amdgcn_fence(__ATOMIC_ACQUIRE, "agent");
            xb_add(&bar[XB_XGEN(b.x)], 1u);
            asm volatile("s_waitcnt vmcnt(0)" ::: "memory");
        } else {
            XB_SPIN(xb_ld(&bar[XB_XGEN(b.x)]) == gen, bar);
            __builtin_amdgcn_fence(__ATOMIC_ACQUIRE, "agent");
            asm volatile("s_waitcnt vmcnt(0)" ::: "memory");
        }
    }
    __syncthreads();
}
constexpr size_t O_YX = 0, O_PAS = O_YX + (size_t)MROWS * D, O_PAC = O_PAS + (size_t)2 * NB * 4 * 128 * 128, O_PBS = O_PAC + (size_t)2 * NB * 3 * 1536, O_PBH = O_PBS + (size_t)2 * NB * 8 * 64 * 64,
                 O_PCH = O_PBH + (size_t)2 * NB * 1792, O_PCC = O_PCH + (size_t)2 * NB * 512, O_SAS = O_PCC + (size_t)2 * NB * 3 * 512, O_SAC = O_SAS + (size_t)2 * NSB * 4 * 128 * 128,
                 O_SBS = O_SAC + (size_t)2 * NSB * 3 * 1536, O_SBH = O_SBS + (size_t)2 * NSB * 8 * 64 * 64, O_SCH = O_SBH + (size_t)2 * NSB * 1792, O_SCC = O_SCH + (size_t)2 * NSB * 512;
struct Frame {
    LAS unsigned char* lds;
    int tid, lane, wave, G, bid;
    const float* const CAS* in;
    float* out;
    unsigned char* ws;
    int omask;
#define FPTR(name, T, expr) __device__ __forceinline__ T* name() const { return (T*)(expr); }
    FPTR(y_x, float, out + O_YX) FPTR(p_a_S, float, out + O_PAS) FPTR(p_a_conv, float, out + O_PAC) FPTR(p_b_S, float, out + O_PBS) FPTR(p_b_shift, float, out + O_PBH) FPTR(p_c_h, float, out + O_PCH) FPTR(p_c_conv, float, out + O_PCC)
    FPTR(s_a_S, float, out + O_SAS) FPTR(s_a_conv, float, out + O_SAC) FPTR(s_b_S, float, out + O_SBS) FPTR(s_b_shift, float, out + O_SBH) FPTR(s_c_h, float, out + O_SCH) FPTR(s_c_conv, float, out + O_SCC)
    FPTR(WIN, bf16, ws + WS_WIN) FPTR(WBR, bf16, ws + WS_WBR) FPTR(WOUT, bf16, ws + WS_WOUT) FPTR(WUP, bf16, ws + WS_WUP) FPTR(WDN, bf16, ws + WS_WDN)
    FPTR(WSP, float, ws + WS_MISCW + MW_WSP) FPTR(WCA, bf16, ws + WS_MISCW + MW_WCA) FPTR(WCX, bf16, ws + WS_MISCW + MW_WCX)
    FPTR(XB, bf16, ws + WS_XB) FPTR(SSQ, float, ws + WS_SSQ) FPTR(BG, float, ws + WS_BG) FPTR(HALO_A, bf16, ws + WS_HALO + HALO_A_OFF) FPTR(HALO_C, bf16, ws + WS_HALO + HALO_C_OFF)
    FPTR(CSUM, float, ws + WS_CSUM) FPTR(GL, float, ws + WS_GL) FPTR(GW, bf16, ws + WS_GW) FPTR(GATT, bf16, ws + WS_GATT) FPTR(Mb, bf16, ws + WS_M) FPTR(Z, bf16, ws + WS_Z)
#undef FPTR
};
__device__ __forceinline__ int opaque_tid(const Frame& F) { int t = F.tid; asm volatile("" : "+v"(t)); return t; }
constexpr int OM_A_S = 1, OM_A_CONV = 2, OM_B_S = 4, OM_B_SHIFT = 8, OM_C_H = 16, OM_C_CONV = 32, OM_Y = 64, OM_ALL = 127;

__device__ __forceinline__ void tr_item(const float* W, int ldw, int src_col0, int k0, const float* kscale, bf16* WT, int ldt, int dst_row0, LAS float* scr, int lane) {
    float v[32];
    const float* src = W + (size_t)(k0 + (lane >> 5)) * ldw + src_col0 + (lane & 31);
#pragma unroll
    for (int i = 0; i < 32; ++i) v[i] = src[(size_t)2 * i * ldw];
    if (kscale) {
#pragma unroll
        for (int i = 0; i < 32; ++i) v[i] *= kscale[k0 + 2 * i + (lane >> 5)]; }
#pragma unroll
    for (int i = 0; i < 32; ++i) scr[(2 * i + (lane >> 5)) * 33 + (lane & 31)] = v[i];
    LDS_WAIT(); asm volatile("" ::: "memory");
    const int c = lane & 7;
#pragma unroll
    for (int j = 0; j < 4; ++j) { const int n = (lane >> 3) + 8 * j; const LAS float* s = scr + (8 * c) * 33 + n;
        v4u o; o.x = pk2(s[0], s[33]); o.y = pk2(s[66], s[99]); o.z = pk2(s[132], s[165]); o.w = pk2(s[198], s[231]);
        *(GAS v4u*)(WT + (size_t)(dst_row0 + n) * ldt + k0 + 8 * c) = o; }
    LDS_WAIT(); asm volatile("" ::: "memory");
}
__device__ __forceinline__ void p0_weights(Frame& F, int l) {
    LAS float* scr = (LAS float*)(F.lds + F.wave * 16384);
    const int gw = F.bid * NWAVES + F.wave, NGW = F.G * NWAVES;
    const float* w_in = F.in[9] + (size_t)l * D * NIN_SRC; const float* g1 = F.in[8] + (size_t)l * D;
    const float* w_br = F.in[32] + (size_t)l * 3 * 512 * D; const float* w_out = F.in[33] + (size_t)l * D * D; const float* g2 = F.in[34] + (size_t)l * D;
    const float* w_up = F.in[35] + (size_t)l * D * DFF; const float* w_dn = F.in[36] + (size_t)l * DFF * D;
    const float* c_wa = F.in[27] + (size_t)l * 8 * 64 * 64; const float* c_wx = F.in[29] + (size_t)l * 8 * 64 * 64;
    constexpr int I_IN = 16 * 248, I_BR = 3 * 8 * 32, I_OUT = 16 * 32, I_UP = 16 * 128, I_DN = 64 * 32, I_C = 32;
    constexpr int NITEMS = I_IN + I_BR + I_OUT + I_UP + I_DN + I_C;
    for (int it = gw; it < NITEMS; it += NGW) {
        int r = it;
        if (r < I_IN) { const int kb = r / 248, nb = r % 248, n0 = nb * 32; tr_item(w_in, NIN_SRC, n0 + (n0 >= 2048 ? 8 : 0), kb * 64, g1, F.WIN(), D, n0, scr, F.lane); continue; } r -= I_IN;
        if (r < I_BR) { const int b = r / 256, q = r % 256, kb = q / 32, nb = q % 32; tr_item(w_br + (size_t)b * 512 * D, D, nb * 32, kb * 64, nullptr, F.WBR() + (size_t)b * D * 512, 512, nb * 32, scr, F.lane); continue; } r -= I_BR;
        if (r < I_OUT) { const int kb = r / 32, nb = r % 32; tr_item(w_out, D, nb * 32, kb * 64, nullptr, F.WOUT(), D, nb * 32, scr, F.lane); continue; } r -= I_OUT;
        if (r < I_UP) { const int kb = r / 128, nb = r % 128; tr_item(w_up, DFF, nb * 32, kb * 64, g2, F.WUP(), D, nb * 32, scr, F.lane); continue; } r -= I_UP;
        if (r < I_DN) { const int kb = r / 32, nb = r % 32; tr_item(w_dn, D, nb * 32, kb * 64, nullptr, F.WDN(), DFF, nb * 32, scr, F.lane); continue; } r -= I_DN;
        { const int which = r / 16, q = r % 16, g = q / 2, nb = q % 2; tr_item((which ? c_wx : c_wa) + (size_t)g * 4096, 64, nb * 32, 0, nullptr, (which ? F.WCX() : F.WCA()) + (size_t)g * 4096, 64, nb * 32, scr, F.lane); }
    }
    for (int i = F.bid * NTHR + F.tid; i < 8 * 1024; i += F.G * NTHR) { const int j = i >> 10, k = i & 1023; F.WSP()[i] = w_in[(size_t)k * NIN_SRC + 2048 + j] * g1[k]; }
}
__device__ __forceinline__ void p0_xb(Frame& F) {
    const int gw = F.bid * NWAVES + F.wave, NGW = F.G * NWAVES;
    for (int m = gw; m < MROWS; m += NGW) {
        const float* xr = (m < MP) ? F.in[0] + (size_t)m * D : F.in[1] + (size_t)(m - MP) * D;
        const f32x4* xp = (const f32x4*)xr + F.lane * 4; float s = 0.f; v4u o0, o1;
        const f32x4 a = xp[0], b = xp[1], c = xp[2], d = xp[3];
        s = (a[0] * a[0] + a[1] * a[1] + a[2] * a[2] + a[3] * a[3]) + (b[0] * b[0] + b[1] * b[1] + b[2] * b[2] + b[3] * b[3]) + (c[0] * c[0] + c[1] * c[1] + c[2] * c[2] + c[3] * c[3]) + (d[0] * d[0] + d[1] * d[1] + d[2] * d[2] + d[3] * d[3]);
        o0.x = pk2(a[0], a[1]); o0.y = pk2(a[2], a[3]); o0.z = pk2(b[0], b[1]); o0.w = pk2(b[2], b[3]);
        o1.x = pk2(c[0], c[1]); o1.y = pk2(c[2], c[3]); o1.z = pk2(d[0], d[1]); o1.w = pk2(d[2], d[3]);
        v4u* dst = (v4u*)(F.XB() + (size_t)m * D) + F.lane * 2; dst[0] = o0; dst[1] = o1;
        s = wave_sum(s);
        if (F.lane < 16) F.SSQ()[(size_t)m * 16 + F.lane] = (F.lane == 0) ? s : 0.f;
    }
}

__device__ __forceinline__ void p2_misc(Frame& F, int l) {
    const int gw = F.bid * NWAVES + F.wave, NGW = F.G * NWAVES, lane = F.lane;
    const float* A_log = F.in[11] + l * 4; const float* dtb = F.in[12] + l * 4;
    {   float wsp[8][16];
#pragma unroll
        for (int j = 0; j < 8; ++j)
#pragma unroll
            for (int e = 0; e < 16; ++e) wsp[j][e] = F.WSP()[j * 1024 + lane * 16 + e];
        for (int m = gw; m < MROWS; m += NGW) {
            const v4u* xp = (const v4u*)(F.XB() + (size_t)m * D) + lane * 2; const v4u x0 = xp[0], x1 = xp[1];
            float xv[16] = {bflo(x0.x), bfhi(x0.x), bflo(x0.y), bfhi(x0.y), bflo(x0.z), bfhi(x0.z), bflo(x0.w), bfhi(x0.w), bflo(x1.x), bfhi(x1.x), bflo(x1.y), bfhi(x1.y), bflo(x1.z), bfhi(x1.z), bflo(x1.w), bfhi(x1.w)};
            const float rs = pg8::row_rstd(F.SSQ(), m);
            float mine = 0.f;
#pragma unroll
            for (int j = 0; j < 8; ++j) { float s = 0.f;
#pragma unroll
                for (int e = 0; e < 16; ++e) s += xv[e] * wsp[j][e];
                s = wave_sum(s) * rs; if (lane == j) mine = s; }
            if (lane < 4) F.BG()[(size_t)m * 8 + lane] = fsigmoid(mine);
            else if (lane < 8) F.BG()[(size_t)m * 8 + lane] = -fexp(A_log[lane - 4]) * fsoftplus(mine + dtb[lane - 4]);
        }
    }
    for (int it = gw; it < NB * 32 * 3; it += NGW) { const int i = it % 3, c = (it / 3) % 32 + 1, b = it / 96; const size_t row = (size_t)b * SEQ + 64 * c - 3 + i;
        const bf16* zr = F.Z() + row * NZ; bf16* ha = F.HALO_A() + ((size_t)(b * 33 + c) * 3 + i) * 1536; bf16* hc = F.HALO_C() + ((size_t)(b * 33 + c) * 3 + i) * 512;
        for (int q = lane; q < 192; q += 64) ((v4u*)ha)[q] = ((const v4u*)zr)[q];
        ((v4u*)hc)[lane] = ((const v4u*)(zr + ZC_X))[lane];
        if (c == 32) {
            if (F.omask & OM_A_CONV) { float* o = F.p_a_conv() + ((size_t)(l * NB + b) * 3 + i) * 1536; for (int q = lane; q < 1536; q += 64) o[q] = bf2f(zr[q]); }
            if (F.omask & OM_C_CONV) { float* o = F.p_c_conv() + ((size_t)(l * NB + b) * 3 + i) * 512; for (int q = lane; q < 512; q += 64) o[q] = bf2f(zr[ZC_X + q]); }
        } }
    if (F.omask & OM_B_SHIFT) for (int b = gw; b < NB; b += NGW) { const bf16* zr = F.Z() + ((size_t)b * SEQ + SEQ - 1) * NZ + ZB_R; float* o = F.p_b_shift() + (size_t)(l * NB + b) * 1792; for (int q = lane; q < 1792; q += 64) o[q] = bf2f(zr[q]); }
    for (int it = gw; it < NSB * 3; it += NGW) { const int i = it % 3, sb = it / 3; const bf16* zr = F.Z() + ((size_t)MP + sb * TS + 1 + i) * NZ;
        if (F.omask & OM_A_CONV) { float* o = F.s_a_conv() + ((size_t)(l * NSB + sb) * 3 + i) * 1536; for (int q = lane; q < 1536; q += 64) o[q] = bf2f(zr[q]); }
        if (F.omask & OM_C_CONV) { float* o = F.s_c_conv() + ((size_t)(l * NSB + sb) * 3 + i) * 512; for (int q = lane; q < 512; q += 64) o[q] = bf2f(zr[ZC_X + q]); }
        if (i == 2 && (F.omask & OM_B_SHIFT)) { float* o = F.s_b_shift() + (size_t)(l * NSB + sb) * 1792; for (int q = lane; q < 1792; q += 64) o[q] = bf2f(zr[ZB_R + q]); } }
}

constexpr int RW_VEC = 0, RW_ABUF = 57344, RW_LOR = 74240, RW_KRAW = 98816, RW_OBUF = 107008, RW_PREV = 115200, RW_BON = 118784;
__device__ __forceinline__ void rwkv_unit(Frame& F, int l, int row0, int T, int h, const float* S0, const float* shift0, float* Sout) {
    const int tid = opaque_tid(F), lane = tid & 63, wv = __builtin_amdgcn_readfirstlane(tid >> 6);
    LAS float* vec = (LAS float*)(F.lds + RW_VEC); LAS bf16* abuf = (LAS bf16*)(F.lds + RW_ABUF); LAS float* lor = (LAS float*)(F.lds + RW_LOR);
    LAS float* kraw = (LAS float*)(F.lds + RW_KRAW); LAS float* obuf = (LAS float*)(F.lds + RW_OBUF); LAS float* prevb = (LAS float*)(F.lds + RW_PREV); LAS float* bon = (LAS float*)(F.lds + RW_BON);
    const float* mu = F.in[14] + (size_t)l * 1792; const float* w0 = F.in[15] + l * 512; const float* w_up = F.in[16] + (size_t)l * 64 * 512; const float* a0 = F.in[17] + l * 512;
    const float* a_up = F.in[18] + (size_t)l * 64 * 512; const float* g_up = F.in[19] + (size_t)l * 128 * 512; const float* k_k = F.in[20] + l * 512; const float* k_a = F.in[21] + l * 512;
    const float* r_k = F.in[22] + l * 512; const float* ln_w = F.in[23] + l * 512; const float* ln_b = F.in[24] + l * 512;
    const int mt = wv >> 2, nt = wv & 3, fq = lane >> 4, fr = lane & 15, hcB = h * 64 + nt * 16 + fr;
    bf16x8 Bw[2], Ba[2], Bg[4];
#pragma unroll
    for (int ks = 0; ks < 2; ++ks)
#pragma unroll
        for (int j = 0; j < 8; ++j) { const int k = 32 * ks + 8 * fq + j; Bw[ks][j] = (short)f2bf(w_up[(size_t)k * 512 + hcB]); Ba[ks][j] = (short)f2bf(a_up[(size_t)k * 512 + hcB]); }
#pragma unroll
    for (int ks = 0; ks < 4; ++ks)
#pragma unroll
        for (int j = 0; j < 8; ++j) { const int k = 32 * ks + 8 * fq + j; Bg[ks][j] = (short)f2bf(g_up[(size_t)k * 512 + hcB]); }
    const int sv = tid >> 3, sk0 = (tid & 7) * 8;
    float S[8];
#pragma unroll
    for (int j = 0; j < 8; ++j) S[j] = S0 ? S0[(size_t)sv * 64 + sk0 + j] : 0.f;
    for (int c = tid; c < 448; c += NTHR) { float p = 0.f;
        if (shift0) { const int zc = (c < 192) ? (ZB_R + (c >> 6) * 512 + h * 64 + (c & 63)) : (ZB_XW + (c - 192)); p = shift0[zc - ZB_R]; }
        prevb[c] = p; }
    __syncthreads();
    int pb = 0;
    for (int t0 = 0; t0 < T; t0 += 32) {
        const int CL = (T - t0) < 32 ? (T - t0) : 32;
        for (int qi = tid; qi < CL * 112; qi += NTHR) { const int i = qi / 112, c = (qi - i * 112) * 4;
            const int zc = (c < 192) ? (ZB_R + (c >> 6) * 512 + h * 64 + (c & 63)) : (ZB_XW + (c - 192));
            float cur[4] = {0.f, 0.f, 0.f, 0.f}, prv[4] = {0.f, 0.f, 0.f, 0.f};
            if (i < CL) { const v2u w = *(const v2u*)(F.Z() + (size_t)(row0 + t0 + i) * NZ + zc); cur[0] = bflo(w.x); cur[1] = bfhi(w.x); cur[2] = bflo(w.y); cur[3] = bfhi(w.y);
                if (i > 0) { const v2u p = *(const v2u*)(F.Z() + (size_t)(row0 + t0 + i - 1) * NZ + zc); prv[0] = bflo(p.x); prv[1] = bfhi(p.x); prv[2] = bflo(p.y); prv[3] = bfhi(p.y); }
                else { prv[0] = prevb[pb * 448 + c]; prv[1] = prevb[pb * 448 + c + 1]; prv[2] = prevb[pb * 448 + c + 2]; prv[3] = prevb[pb * 448 + c + 3]; }
                if (i == CL - 1) { prevb[(pb ^ 1) * 448 + c] = cur[0]; prevb[(pb ^ 1) * 448 + c + 1] = cur[1]; prevb[(pb ^ 1) * 448 + c + 2] = cur[2]; prevb[(pb ^ 1) * 448 + c + 3] = cur[3]; } }
            float zs[4];
#pragma unroll
            for (int j = 0; j < 4; ++j) zs[j] = cur[j] + (prv[j] - cur[j]) * mu[zc - ZB_R + j];
            if (c < 64) { LAS float* d = vec + (i * 7 + 4) * 64 + c; d[0] = zs[0]; d[1] = zs[1]; d[2] = zs[2]; d[3] = zs[3]; }
            else if (c < 128) { LAS float* d = kraw + i * 64 + (c - 64); d[0] = zs[0]; d[1] = zs[1]; d[2] = zs[2]; d[3] = zs[3]; }
            else if (c < 192) { LAS float* d = vec + (i * 7 + 5) * 64 + (c - 128); d[0] = zs[0]; d[1] = zs[1]; d[2] = zs[2]; d[3] = zs[3]; }
            else { const int cc = c - 192; float t4[4];
#pragma unroll
                for (int j = 0; j < 4; ++j) t4[j] = (cc < 64) ? ftanh(zs[j]) : ((cc < 128) ? zs[j] : fsigmoid(zs[j]));
                v2u w; w.x = pk2(t4[0], t4[1]); w.y = pk2(t4[2], t4[3]); *(LAS v2u*)(abuf + i * 264 + cc) = w; }
        }
        __syncthreads();
        {   f32x4 aw = {0.f, 0.f, 0.f, 0.f}, aa = aw, ag = aw;
            const LAS bf16* arow = abuf + (mt * 16 + fr) * 264 + 8 * fq;
#pragma unroll
            for (int ks = 0; ks < 2; ++ks) { const bf16x8 A1 = *(const LAS bf16x8*)(arow + 32 * ks), A2 = *(const LAS bf16x8*)(arow + 64 + 32 * ks);
                aw = __builtin_amdgcn_mfma_f32_16x16x32_bf16(A1, Bw[ks], aw, 0, 0, 0); aa = __builtin_amdgcn_mfma_f32_16x16x32_bf16(A2, Ba[ks], aa, 0, 0, 0); }
#pragma unroll
            for (int ks = 0; ks < 4; ++ks) { const bf16x8 A3 = *(const LAS bf16x8*)(arow + 128 + 32 * ks); ag = __builtin_amdgcn_mfma_f32_16x16x32_bf16(A3, Bg[ks], ag, 0, 0, 0); }
#pragma unroll
            for (int r = 0; r < 4; ++r) { const int tok = mt * 16 + 4 * fq + r, n = nt * 16 + fr; lor[(tok * 3 + 0) * 64 + n] = aw[r]; lor[(tok * 3 + 1) * 64 + n] = aa[r]; lor[(tok * 3 + 2) * 64 + n] = ag[r]; }
        }
        __syncthreads();
        {   const int i = tid >> 4, c0 = (tid & 15) * 4; float ss = 0.f, bs = 0.f; float kkv[4], av[4];
#pragma unroll
            for (int j = 0; j < 4; ++j) { const int c = c0 + j, hc = h * 64 + c;
                const float wl = lor[(i * 3 + 0) * 64 + c], al = lor[(i * 3 + 1) * 64 + c], gl = lor[(i * 3 + 2) * 64 + c];
                const float wlog = -fsoftplus(-(w0[hc] + wl)) - 0.5f; const float wdec = fexp(-fexp(wlog));
                const float a = fsigmoid(a0[hc] + al); const float kr = kraw[i * 64 + c]; const float kk = kr * k_k[hc];
                const float kp = kr * (1.f + (a - 1.f) * k_a[hc]);
                kkv[j] = kk; av[j] = a; ss += kk * kk; bs += vec[(i * 7 + 4) * 64 + c] * kp * r_k[hc];
                vec[(i * 7 + 1) * 64 + c] = wdec; vec[(i * 7 + 3) * 64 + c] = kp; vec[(i * 7 + 6) * 64 + c] = gl; }
            ss = sum16(ss); bs = sum16(bs); const float rn = __builtin_amdgcn_rsqf(ss + EPS);
#pragma unroll
            for (int j = 0; j < 4; ++j) { const int c = c0 + j; const float kn = kkv[j] * rn; vec[(i * 7 + 0) * 64 + c] = -kn; vec[(i * 7 + 2) * 64 + c] = kn * av[j]; }
            if ((tid & 15) == 0) bon[i] = bs;
        }
        __syncthreads();
        for (int t = 0; t < CL; ++t) {
            const LAS float* vp = vec + t * 7 * 64;
            const f32x4 n0 = *(const LAS f32x4*)(vp + 0 * 64 + sk0), n1 = *(const LAS f32x4*)(vp + 0 * 64 + sk0 + 4);
            const f32x4 w0v = *(const LAS f32x4*)(vp + 1 * 64 + sk0), w1v = *(const LAS f32x4*)(vp + 1 * 64 + sk0 + 4);
            const f32x4 a0v = *(const LAS f32x4*)(vp + 2 * 64 + sk0), a1v = *(const LAS f32x4*)(vp + 2 * 64 + sk0 + 4);
            const f32x4 k0v = *(const LAS f32x4*)(vp + 3 * 64 + sk0), k1v = *(const LAS f32x4*)(vp + 3 * 64 + sk0 + 4);
            const f32x4 r0v = *(const LAS f32x4*)(vp + 4 * 64 + sk0), r1v = *(const LAS f32x4*)(vp + 4 * 64 + sk0 + 4);
            const float vv = vp[5 * 64 + sv];
            float sa = (S[0] * n0[0] + S[1] * n0[1]) + (S[2] * n0[2] + S[3] * n0[3]) + (S[4] * n1[0] + S[5] * n1[1]) + (S[6] * n1[2] + S[7] * n1[3]);
            sa = sum8(sa);
            S[0] = S[0] * w0v[0] + sa * a0v[0] + vv * k0v[0]; S[1] = S[1] * w0v[1] + sa * a0v[1] + vv * k0v[1]; S[2] = S[2] * w0v[2] + sa * a0v[2] + vv * k0v[2]; S[3] = S[3] * w0v[3] + sa * a0v[3] + vv * k0v[3];
            S[4] = S[4] * w1v[0] + sa * a1v[0] + vv * k1v[0]; S[5] = S[5] * w1v[1] + sa * a1v[1] + vv * k1v[1]; S[6] = S[6] * w1v[2] + sa * a1v[2] + vv * k1v[2]; S[7] = S[7] * w1v[3] + sa * a1v[3] + vv * k1v[3];
            float oo = (S[0] * r0v[0] + S[1] * r0v[1]) + (S[2] * r0v[2] + S[3] * r0v[3]) + (S[4] * r1v[0] + S[5] * r1v[1]) + (S[6] * r1v[2] + S[7] * r1v[3]);
            oo = sum8(oo);
            if ((tid & 7) == 0) obuf[t * 64 + sv] = oo;
        }
        __syncthreads();
        {   const int i = tid >> 4, c0 = (tid & 15) * 4; float o4[4]; float s = 0.f;
#pragma unroll
            for (int j = 0; j < 4; ++j) { o4[j] = obuf[i * 64 + c0 + j]; s += o4[j]; }
            const float mean = sum16(s) * (1.f / 64.f); float q = 0.f;
#pragma unroll
            for (int j = 0; j < 4; ++j) { o4[j] -= mean; q += o4[j] * o4[j]; }
            const float rstd = __builtin_amdgcn_rsqf(sum16(q) * (1.f / 64.f) + B_LN_EPS); const float bo = bon[i];
            float y[4];
#pragma unroll
            for (int j = 0; j < 4; ++j) { const int c = c0 + j, hc = h * 64 + c; y[j] = (o4[j] * rstd * ln_w[hc] + ln_b[hc] + bo * vec[(i * 7 + 5) * 64 + c]) * vec[(i * 7 + 6) * 64 + c]; }
            if (i < CL) { v2u w; w.x = pk2(y[0], y[1]); w.y = pk2(y[2], y[3]); *(v2u*)(F.Z() + (size_t)(row0 + t0 + i) * NZ + ZB_R + h * 64 + c0) = w; }
        }
        __syncthreads();
        pb ^= 1;
    }
    if (F.omask & OM_B_S) {
#pragma unroll
        for (int j = 0; j < 8; ++j) Sout[(size_t)sv * 64 + sk0 + j] = S[j]; }
}

template <int I> struct SolveRows {
    static __device__ __forceinline__ void run(float (&X)[64], const LAS float* Lm, const LAS bf16* src, const LAS float* gcs, int cc, bool isk) {
        SolveRows<I - 1>::run(X, Lm, src, gcs, cc, isk);
        const float eg = gcs[128 + I]; float r = bf2f(src[I * 136 + cc]) * gcs[64 + I] * (isk ? eg : 1.0f);
#pragma unroll
        for (int j4 = 0; j4 < (I + 3) / 4; ++j4) { const f32x4 lv = *(const LAS f32x4*)(Lm + I * 64 + 4 * j4);
#pragma unroll
            for (int e = 0; e < 4; ++e) if (4 * j4 + e < I) r -= lv[e] * X[4 * j4 + e]; }
        X[I] = r; asm volatile("" ::: "memory"); }
};
template <> struct SolveRows<-1> { static __device__ __forceinline__ void run(float (&)[64], const LAS float*, const LAS bf16*, const LAS float*, int, bool) {} };
constexpr int AP_Q = 0, AP_K = 17408, AP_V = 34816, AP_L = 52224, AP_AT = 68608, AP_GC = 77824;
__device__ __forceinline__ void gdn_prep_unit(Frame& F, int l, int b, int c, int h) {
    const int tid = opaque_tid(F), lane = tid & 63, wv = __builtin_amdgcn_readfirstlane(tid >> 6);
    LAS bf16* qs = (LAS bf16*)(F.lds + AP_Q); LAS bf16* ks = (LAS bf16*)(F.lds + AP_K); LAS bf16* vs = (LAS bf16*)(F.lds + AP_V);
    LAS float* Lm = (LAS float*)(F.lds + AP_L); LAS bf16* at = (LAS bf16*)(F.lds + AP_AT); LAS float* gcs = (LAS float*)(F.lds + AP_GC);
    const float* conv_w = F.in[10] + (size_t)l * 4 * 1536;
    const size_t t0 = (size_t)b * SEQ + 64 * c; const int unit = (b * 32 + c) * 4 + h;
    {   const int tok = tid >> 3, cg = tid & 7;
#pragma unroll
        for (int seg = 0; seg < 3; ++seg) { const int col = seg * 512 + h * 128 + cg * 16; float acc[16];
#pragma unroll
            for (int e = 0; e < 16; ++e) acc[e] = 0.f;
#pragma unroll
            for (int tap = 0; tap < 4; ++tap) { const int j = tok + tap - 3; v4u x0 = {0u, 0u, 0u, 0u}, x1 = x0;
                if (j >= 0) { const v4u* p = (const v4u*)(F.Z() + (t0 + j) * NZ + col); x0 = p[0]; x1 = p[1]; }
                else if (c > 0) { const v4u* p = (const v4u*)(F.HALO_A() + ((size_t)(b * 33 + c) * 3 + (3 + j)) * 1536 + col); x0 = p[0]; x1 = p[1]; }
                const f32x4* wp = (const f32x4*)(conv_w + tap * 1536 + col); const f32x4 wa = wp[0], wb = wp[1], wc = wp[2], wd = wp[3];
                acc[0] += bflo(x0.x) * wa[0]; acc[1] += bfhi(x0.x) * wa[1]; acc[2] += bflo(x0.y) * wa[2]; acc[3] += bfhi(x0.y) * wa[3];
                acc[4] += bflo(x0.z) * wb[0]; acc[5] += bfhi(x0.z) * wb[1]; acc[6] += bflo(x0.w) * wb[2]; acc[7] += bfhi(x0.w) * wb[3];
                acc[8] += bflo(x1.x) * wc[0]; acc[9] += bfhi(x1.x) * wc[1]; acc[10] += bflo(x1.y) * wc[2]; acc[11] += bfhi(x1.y) * wc[3];
                acc[12] += bflo(x1.z) * wd[0]; acc[13] += bfhi(x1.z) * wd[1]; acc[14] += bflo(x1.w) * wd[2]; acc[15] += bfhi(x1.w) * wd[3]; }
            float ss = 0.f;
#pragma unroll
            for (int e = 0; e < 16; ++e) { acc[e] = fsilu(acc[e]); ss += acc[e] * acc[e]; }
            float sc = 1.f;
            if (seg < 2) { ss = sum8(ss); sc = __builtin_amdgcn_rsqf(ss + EPS); if (seg == 0) sc *= 0.08838834764831845f; }
            v4u o0, o1; o0.x = pk2(acc[0] * sc, acc[1] * sc); o0.y = pk2(acc[2] * sc, acc[3] * sc); o0.z = pk2(acc[4] * sc, acc[5] * sc); o0.w = pk2(acc[6] * sc, acc[7] * sc);
            o1.x = pk2(acc[8] * sc, acc[9] * sc); o1.y = pk2(acc[10] * sc, acc[11] * sc); o1.z = pk2(acc[12] * sc, acc[13] * sc); o1.w = pk2(acc[14] * sc, acc[15] * sc);
            LAS bf16* dst = (seg == 0 ? qs : (seg == 1 ? ks : vs)) + tok * 136 + cg * 16; *(LAS v4u*)dst = o0; *(LAS v4u*)(dst + 8) = o1; }
    }
    if (wv == 0) { const float g0 = F.BG()[(t0 + lane) * 8 + 4 + h]; const float be = F.BG()[(t0 + lane) * 8 + h];
        gcs[192 + lane] = g0; LDS_WAIT();
        float g = 0.f, glast = 0.f;
#pragma unroll 8
        for (int j = 0; j < 64; ++j) { const float v = gcs[192 + j]; glast += v; g += (j <= lane) ? v : 0.f; }
        LDS_WAIT();
        gcs[lane] = g; gcs[64 + lane] = be; gcs[128 + lane] = fexp(g); gcs[192 + lane] = fexp(glast - g);
        if (lane == 63) F.GL()[unit] = fexp(g); }
    __syncthreads();
    {   const int p = wv >> 2, mt = wv & 3, fq = lane >> 4, fr = lane & 15;
        const LAS bf16* Ar = (p == 0 ? ks : qs) + (mt * 16 + fr) * 136 + 8 * fq;
#pragma unroll
        for (int nt = 0; nt < 4; ++nt) { f32x4 acc = {0.f, 0.f, 0.f, 0.f};
            if (nt <= mt) { const LAS bf16* Br = ks + (nt * 16 + fr) * 136 + 8 * fq;
#pragma unroll
                for (int kst = 0; kst < 4; ++kst) acc = __builtin_amdgcn_mfma_f32_16x16x32_bf16(*(const LAS bf16x8*)(Ar + 32 * kst), *(const LAS bf16x8*)(Br + 32 * kst), acc, 0, 0, 0); }
#pragma unroll
            for (int r = 0; r < 4; ++r) { const int i = mt * 16 + 4 * fq + r, j = nt * 16 + fr; const float dec = fexp(fminf(gcs[i] - gcs[j], 0.f));
                if (p == 0) Lm[i * 64 + j] = (i > j) ? gcs[64 + i] * acc[r] * dec : 0.f;
                else at[i * 72 + j] = (bf16)f2bf((i >= j) ? acc[r] * dec : 0.f); } }
    }
    __syncthreads();
    if (tid < 256) {
        float X[64]; const int cc = tid & 127;
        SolveRows<63>::run(X, Lm, (tid < 128) ? vs : ks, gcs, cc, tid >= 128);
        if (tid < 128) {
#pragma unroll
            for (int i = 0; i < 64; ++i) F.Z()[(t0 + i) * NZ + ZA_V + h * 128 + cc] = (bf16)f2bf(X[i]); }
        else {
#pragma unroll
            for (int i = 0; i < 64; ++i) F.GW()[(size_t)unit * 8192 + i * 128 + cc] = (bf16)f2bf(X[i]); }
    } else {
        const int t2 = tid - 256;
        for (int ch = t2; ch < 1024; ch += 256) { const int i = ch >> 4, d0 = (ch & 15) * 8; const v4u q = *(const LAS v4u*)(qs + i * 136 + d0); const float e = gcs[128 + i];
            v4u o; o.x = pk2(bflo(q.x) * e, bfhi(q.x) * e); o.y = pk2(bflo(q.y) * e, bfhi(q.y) * e); o.z = pk2(bflo(q.z) * e, bfhi(q.z) * e); o.w = pk2(bflo(q.w) * e, bfhi(q.w) * e);
            *(v4u*)(F.Z() + (t0 + i) * NZ + ZA_Q + h * 128 + d0) = o; }
        for (int ch = t2; ch < 1024; ch += 256) { const int kd = ch >> 3, tg = ch & 7; float v[8];
#pragma unroll
            for (int j = 0; j < 8; ++j) v[j] = bf2f(ks[(8 * tg + j) * 136 + kd]) * gcs[192 + 8 * tg + j];
            v4u o; o.x = pk2(v[0], v[1]); o.y = pk2(v[2], v[3]); o.z = pk2(v[4], v[5]); o.w = pk2(v[6], v[7]);
            *(v4u*)(F.Z() + (t0 + (kd >> 1)) * NZ + ZA_K + h * 128 + (kd & 1) * 64 + 8 * tg) = o; }
        for (int ch = t2; ch < 512; ch += 256) { const int i = ch >> 3, j0 = (ch & 7) * 8; *(v4u*)(F.GATT() + (size_t)unit * 4096 + i * 64 + j0) = *(const LAS v4u*)(at + i * 72 + j0); }
    }
    __syncthreads();
}

constexpr int AS_W = 0, AS_QG = 17408, AS_U = 34816, AS_KT = 52224, AS_AT = 70656, AS_G = 79872, AS_PS = 97280, AS_RS = 99328;
__device__ __forceinline__ bf16x8 frag_perm(const LAS bf16* rowp) {
    const bf16x4 lo = *(const LAS bf16x4*)rowp, hi = *(const LAS bf16x4*)(rowp + 16);
    return (bf16x8){lo[0], lo[1], lo[2], lo[3], hi[0], hi[1], hi[2], hi[3]};
}
__device__ __forceinline__ bf16x8 pack_acc(const f32x4 a, const f32x4 b) {
    const unsigned w0 = pg8::cvt_pk_bf16(a[0], a[1]), w1 = pg8::cvt_pk_bf16(a[2], a[3]), w2 = pg8::cvt_pk_bf16(b[0], b[1]), w3 = pg8::cvt_pk_bf16(b[2], b[3]);
    const v4u w = {w0, w1, w2, w3}; return __builtin_bit_cast(bf16x8, w);
}
__device__ __forceinline__ void gdn_scan_unit(Frame& F, int l, int b, int h) {
    const int tid = opaque_tid(F), lane = tid & 63, e = __builtin_amdgcn_readfirstlane(tid >> 6), fq = lane >> 4, fr = lane & 15, dv = 16 * e + fr;
    LAS bf16* wS = (LAS bf16*)(F.lds + AS_W); LAS bf16* qgS = (LAS bf16*)(F.lds + AS_QG); LAS bf16* uS = (LAS bf16*)(F.lds + AS_U);
    LAS bf16* ktS = (LAS bf16*)(F.lds + AS_KT); LAS bf16* atS = (LAS bf16*)(F.lds + AS_AT); LAS bf16* gS = (LAS bf16*)(F.lds + AS_G);
    LAS float* ps = (LAS float*)(F.lds + AS_PS); LAS float* rsv = (LAS float*)(F.lds + AS_RS);
    const float ng = (F.in[13] + l * 128)[dv];
    f32x4 S[8];
#pragma unroll
    for (int t = 0; t < 8; ++t) S[t] = (f32x4){0.f, 0.f, 0.f, 0.f};
    v4u pw[2], pq[2], pu[2], pk[2], pg[2], pa; float pgl;
    const int i0 = tid >> 4, d0 = (tid & 15) * 8;
#define AS_FETCH(c) do { const size_t _t0 = (size_t)b * SEQ + 64 * (c); const int _un = (b * 32 + (c)) * 4 + h; \
        _Pragma("unroll") for (int _j = 0; _j < 2; ++_j) { const int _i = i0 + 32 * _j; const bf16* _zr = F.Z() + (_t0 + _i) * NZ + h * 128 + d0; \
            pw[_j] = *(const v4u*)(F.GW() + (size_t)_un * 8192 + _i * 128 + d0); pq[_j] = *(const v4u*)(_zr + ZA_Q); pu[_j] = *(const v4u*)(_zr + ZA_V); pk[_j] = *(const v4u*)(_zr + ZA_K); pg[_j] = *(const v4u*)(_zr + ZA_G); } \
        pa = *(const v4u*)(F.GATT() + (size_t)_un * 4096 + (tid >> 3) * 64 + (tid & 7) * 8); pgl = F.GL()[_un]; } while (0)
    AS_FETCH(0);
    float yprev[4][4];
    for (int c = 0; c < 32; ++c) {
        const size_t t0 = (size_t)b * SEQ + 64 * c;
#pragma unroll
        for (int j = 0; j < 2; ++j) { const int i = i0 + 32 * j;
            *(LAS v4u*)(wS + i * 136 + d0) = pw[j]; *(LAS v4u*)(qgS + i * 136 + d0) = pq[j]; *(LAS v4u*)(uS + i * 136 + d0) = pu[j]; *(LAS v4u*)(gS + i * 136 + d0) = pg[j];
            { const int part = tid & 15; *(LAS v4u*)(ktS + (2 * i + (part >> 3)) * 72 + (part & 7) * 8) = pk[j]; } }
        *(LAS v4u*)(atS + (tid >> 3) * 72 + (tid & 7) * 8) = pa;
        const float glast = pgl;
        __syncthreads();
        if (c > 0) {
#pragma unroll
            for (int mt = 0; mt < 4; ++mt)
#pragma unroll
                for (int r = 0; r < 4; ++r) F.Z()[(t0 - 64 + 16 * mt + 4 * fq + r) * NZ + ZA_G + h * 128 + dv] = (bf16)f2bf(yprev[mt][r]); }
        if (c + 1 < 32) AS_FETCH(c + 1);
        bf16x8 Sb[4];
#pragma unroll
        for (int kt = 0; kt < 4; ++kt) Sb[kt] = pack_acc(S[2 * kt], S[2 * kt + 1]);
        f32x4 vn[4], oo[4];
#pragma unroll
        for (int mt = 0; mt < 4; ++mt) { f32x4 pw_ = {0.f, 0.f, 0.f, 0.f}, po = pw_;
            bf16x8 fw[4], fqg[4];
#pragma unroll
            for (int kt = 0; kt < 4; ++kt) { fw[kt] = frag_perm(wS + (16 * mt + fr) * 136 + 32 * kt + 4 * fq); fqg[kt] = frag_perm(qgS + (16 * mt + fr) * 136 + 32 * kt + 4 * fq); }
            float u4[4];
#pragma unroll
            for (int r = 0; r < 4; ++r) u4[r] = bf2f(uS[(16 * mt + 4 * fq + r) * 136 + dv]);
#pragma unroll
            for (int kt = 0; kt < 4; ++kt) { pw_ = __builtin_amdgcn_mfma_f32_16x16x32_bf16(fw[kt], Sb[kt], pw_, 0, 0, 0); po = __builtin_amdgcn_mfma_f32_16x16x32_bf16(fqg[kt], Sb[kt], po, 0, 0, 0); }
#pragma unroll
            for (int r = 0; r < 4; ++r) vn[mt][r] = u4[r] - pw_[r];
            oo[mt] = po; }
        bf16x8 Vb[2];
        Vb[0] = pack_acc(vn[0], vn[1]); Vb[1] = pack_acc(vn[2], vn[3]);
        {   bf16x8 fat[4][2];
#pragma unroll
            for (int mt = 0; mt < 4; ++mt)
#pragma unroll
                for (int k2 = 0; k2 < 2; ++k2) fat[mt][k2] = frag_perm(atS + (16 * mt + fr) * 72 + 32 * k2 + 4 * fq);
#pragma unroll
            for (int mt = 0; mt < 4; ++mt)
#pragma unroll
                for (int k2 = 0; k2 < 2; ++k2) oo[mt] = __builtin_amdgcn_mfma_f32_16x16x32_bf16(fat[mt][k2], Vb[k2], oo[mt], 0, 0, 0); }
#pragma unroll
        for (int th = 0; th < 2; ++th) { bf16x8 fkt[4][2];
#pragma unroll
            for (int t = 0; t < 4; ++t)
#pragma unroll
                for (int k2 = 0; k2 < 2; ++k2) fkt[t][k2] = frag_perm(ktS + (16 * (4 * th + t) + fr) * 72 + 32 * k2 + 4 * fq);
#pragma unroll
            for (int t = 0; t < 4; ++t) { f32x4 a = S[4 * th + t] * glast;
#pragma unroll
                for (int k2 = 0; k2 < 2; ++k2) a = __builtin_amdgcn_mfma_f32_16x16x32_bf16(fkt[t][k2], Vb[k2], a, 0, 0, 0);
                S[4 * th + t] = a; } }
        float gate[4][4];
#pragma unroll
        for (int mt = 0; mt < 4; ++mt)
#pragma unroll
            for (int r = 0; r < 4; ++r) { gate[mt][r] = bf2f(gS[(16 * mt + 4 * fq + r) * 136 + dv]); const float q = sum16(oo[mt][r] * oo[mt][r]); if (fr == 0) ps[e * 64 + 16 * mt + 4 * fq + r] = q; }
        __syncthreads();
        if (tid < 64) { float s = 0.f;
#pragma unroll
            for (int w = 0; w < 8; ++w) s += ps[w * 64 + tid];
            rsv[tid] = __builtin_amdgcn_rsqf(s * (1.f / 128.f) + EPS); }
        __syncthreads();
#pragma unroll
        for (int mt = 0; mt < 4; ++mt)
#pragma unroll
            for (int r = 0; r < 4; ++r) { const int tok = 16 * mt + 4 * fq + r; yprev[mt][r] = oo[mt][r] * rsv[tok] * ng * fsilu(gate[mt][r]); }
        __syncthreads();
    }
    {   const size_t t0 = (size_t)b * SEQ + 64 * 32;
#pragma unroll
        for (int mt = 0; mt < 4; ++mt)
#pragma unroll
            for (int r = 0; r < 4; ++r) F.Z()[(t0 - 64 + 16 * mt + 4 * fq + r) * NZ + ZA_G + h * 128 + dv] = (bf16)f2bf(yprev[mt][r]); }
#undef AS_FETCH
    if (F.omask & OM_A_S) { float* o = F.p_a_S() + ((size_t)(l * NB + b) * 4 + h) * 128 * 128;
#pragma unroll
        for (int t = 0; t < 8; ++t)
#pragma unroll
            for (int r = 0; r < 4; ++r) o[(size_t)(16 * t + 4 * fq + r) * 128 + dv] = S[t][r]; }
}

constexpr int GS_QKV = 0, GS_PART = 2048, GS_PART2 = 4096, GS_RED = 6144;
__device__ __forceinline__ void gdn_sample_unit(Frame& F, int l, int sb, int h) {
    const int tid = opaque_tid(F), lane = tid & 63, wv = __builtin_amdgcn_readfirstlane(tid >> 6), dv = tid & 127, kg = tid >> 7;
    LAS float* qkv = (LAS float*)(F.lds + GS_QKV); LAS float* part = (LAS float*)(F.lds + GS_PART); LAS float* part2 = (LAS float*)(F.lds + GS_PART2); LAS float* red = (LAS float*)(F.lds + GS_RED);
    const float* conv_w = F.in[10] + (size_t)l * 4 * 1536; const float* cst = F.in[3] + ((size_t)l * NSB + sb) * 3 * 1536;
    const float* S0 = F.in[2] + (((size_t)l * NSB + sb) * 4 + h) * 128 * 128; const float ng = (F.in[13] + l * 128)[dv];
    float S[32];
#pragma unroll
    for (int j = 0; j < 32; ++j) S[j] = S0[(size_t)(32 * kg + j) * 128 + dv];
    for (int t = 0; t < TS; ++t) {
        const size_t row = (size_t)MP + sb * TS + t;
        if (tid < 384) { const int seg = tid >> 7, col = seg * 512 + h * 128 + dv; float y = 0.f;
#pragma unroll
            for (int tap = 0; tap < 4; ++tap) { const int j = t + tap - 3; const float x = (j >= 0) ? bf2f(F.Z()[((size_t)MP + sb * TS + j) * NZ + col]) : cst[(size_t)(j + 3) * 1536 + col]; y += x * conv_w[tap * 1536 + col]; }
            y = fsilu(y); qkv[seg * 128 + dv] = y;
            if (seg < 2) { const float ss = wave_sum(y * y); if (lane == 0) red[wv] = ss; } }
        __syncthreads();
        const float rnq = __builtin_amdgcn_rsqf(red[0] + red[1] + EPS) * 0.08838834764831845f, rnk = __builtin_amdgcn_rsqf(red[2] + red[3] + EPS);
        const float beta = F.BG()[row * 8 + h], eg = fexp(F.BG()[row * 8 + 4 + h]);
        float pd = 0.f;
#pragma unroll
        for (int j = 0; j < 32; ++j) { S[j] *= eg; pd += S[j] * qkv[128 + 32 * kg + j]; }
        part[kg * 128 + dv] = pd * rnk;
        __syncthreads();
        const float tot = (part[dv] + part[128 + dv]) + (part[256 + dv] + part[384 + dv]);
        const float dd = beta * (qkv[256 + dv] - tot) * rnk; float po = 0.f;
#pragma unroll
        for (int j = 0; j < 32; ++j) { S[j] += qkv[128 + 32 * kg + j] * dd; po += S[j] * qkv[32 * kg + j]; }
        part2[kg * 128 + dv] = po * rnq;
        __syncthreads();
        float o = 0.f;
        if (kg == 0) { o = (part2[dv] + part2[128 + dv]) + (part2[256 + dv] + part2[384 + dv]); const float ss = wave_sum(o * o); if (lane == 0) red[4 + wv] = ss; }
        __syncthreads();
        if (kg == 0) { const float rs = __builtin_amdgcn_rsqf((red[4] + red[5]) * (1.f / 128.f) + EPS); bf16* gp = F.Z() + row * NZ + ZA_G + h * 128 + dv;
            *gp = (bf16)f2bf(o * rs * ng * fsilu(bf2f(*gp))); }
        __syncthreads();
    }
    if (F.omask & OM_A_S) { float* o = F.s_a_S() + (((size_t)l * NSB + sb) * 4 + h) * 128 * 128;
#pragma unroll
        for (int j = 0; j < 32; ++j) o[(size_t)(32 * kg + j) * 128 + dv] = S[j]; }
}

constexpr int CP_XA = 0, CP_RI = 66560;
template <bool SAMPLE>
__device__ __forceinline__ void rglru_prep_unit(Frame& F, int l, int b, int c) {
    const int tid = opaque_tid(F), lane = tid & 63, g = __builtin_amdgcn_readfirstlane(tid >> 6), fq = lane >> 4, fr = lane & 15, ch = tid;
    LAS bf16* xa = (LAS bf16*)(F.lds + CP_XA); LAS float* ri = (LAS float*)(F.lds + CP_RI);
    const float* cw = F.in[25] + (size_t)l * 4 * 512; const float cb = (F.in[26] + l * 512)[ch];
    const float* ba = F.in[28] + l * 512; const float* bx = F.in[30] + l * 512; const float cL = (F.in[31] + l * 512)[ch];
    const size_t t0 = SAMPLE ? (size_t)MP + 64 * b : (size_t)b * SEQ + 64 * c;
    const float w0 = cw[ch], w1 = cw[512 + ch], w2 = cw[1024 + ch], w3 = cw[1536 + ch];
    {   float xm3 = 0.f, xm2 = 0.f, xm1 = 0.f;
        if (!SAMPLE && c > 0) { const bf16* hp = F.HALO_C() + (size_t)(b * 33 + c) * 3 * 512 + ch; xm3 = bf2f(hp[0]); xm2 = bf2f(hp[512]); xm1 = bf2f(hp[1024]); }
#pragma unroll 1
        for (int tb = 0; tb < 64; tb += 16) { float xr[16];
#pragma unroll
            for (int t = 0; t < 16; ++t) xr[t] = bf2f(F.Z()[(t0 + tb + t) * NZ + ZC_X + ch]);
#pragma unroll
            for (int t = 0; t < 16; ++t) {
                if (SAMPLE && (t & 3) == 0) { const float* sp = F.in[7] + ((size_t)l * NSB + 16 * b + ((tb + t) >> 2)) * 3 * 512 + ch; xm3 = sp[0]; xm2 = sp[512]; xm1 = sp[1024]; }
                const float x = xr[t];
                const float v = w0 * xm3 + w1 * xm2 + w2 * xm1 + w3 * x + cb; xm3 = xm2; xm2 = xm1; xm1 = x;
                xa[(tb + t) * 520 + ch] = (bf16)f2bf(v); } } }
    bf16x8 Ba[4][2], Bx[4][2];
#pragma unroll
    for (int nt = 0; nt < 4; ++nt)
#pragma unroll
        for (int ks = 0; ks < 2; ++ks) { Ba[nt][ks] = *(const bf16x8*)(F.WCA() + (size_t)g * 4096 + (16 * nt + fr) * 64 + 32 * ks + 8 * fq); Bx[nt][ks] = *(const bf16x8*)(F.WCX() + (size_t)g * 4096 + (16 * nt + fr) * 64 + 32 * ks + 8 * fq); }
    const float sp = fsoftplus(-cL);
    float P = 1.f, hl = 0.f;
    __syncthreads();
#pragma unroll
    for (int mt = 0; mt < 4; ++mt) {
        {   f32x4 ar[4], ai[4];
#pragma unroll
            for (int nt = 0; nt < 4; ++nt) { ar[nt] = (f32x4){0.f, 0.f, 0.f, 0.f}; ai[nt] = ar[nt]; }
#pragma unroll
            for (int ks = 0; ks < 2; ++ks) { const bf16x8 A = *(const LAS bf16x8*)(xa + (16 * mt + fr) * 520 + g * 64 + 32 * ks + 8 * fq);
#pragma unroll
                for (int nt = 0; nt < 4; ++nt) { ar[nt] = __builtin_amdgcn_mfma_f32_16x16x32_bf16(A, Ba[nt][ks], ar[nt], 0, 0, 0); ai[nt] = __builtin_amdgcn_mfma_f32_16x16x32_bf16(A, Bx[nt][ks], ai[nt], 0, 0, 0); } }
#pragma unroll
            for (int nt = 0; nt < 4; ++nt) { const int co = g * 64 + 16 * nt + fr; const float bav = ba[co], bxv = bx[co];
#pragma unroll
                for (int r = 0; r < 4; ++r) { const int tl = 4 * fq + r; *(LAS f32x2*)(ri + (tl * 512 + co) * 2) = (f32x2){fsigmoid(ar[nt][r] + bav), fsigmoid(ai[nt][r] + bxv)}; } }
        }
        __syncthreads();
        float gbv[16];
#pragma unroll
        for (int tl = 0; tl < 16; ++tl) gbv[tl] = bf2f(F.Z()[(t0 + 16 * mt + tl) * NZ + ZC_G + ch]);
#pragma unroll
        for (int tl = 0; tl < 16; ++tl) { const int t = 16 * mt + tl; const f32x2 rv = *(const LAS f32x2*)(ri + (tl * 512 + ch) * 2);
            const float log_a = -8.f * rv[0] * sp; const float a = fexp(log_a); const float bb = sqrtf(fmaxf(-expm1f(2.f * log_a), 0.f)) * (rv[1] * bf2f(xa[t * 520 + ch]));
            bf16* gp = F.Z() + (t0 + t) * NZ + ZC_G + ch; const float ge = fgelu(gbv[tl]);
            if (SAMPLE) {
                if ((t & 3) == 0) hl = (F.in[6] + ((size_t)l * NSB + 16 * b + (t >> 2)) * 512)[ch];
                hl = a * hl + bb; *gp = (bf16)f2bf(hl * ge);
                if ((t & 3) == 3 && (F.omask & OM_C_H)) (F.s_c_h() + ((size_t)l * NSB + 16 * b + (t >> 2)) * 512)[ch] = hl;
            } else { P *= a; hl = a * hl + bb; F.Z()[(t0 + t) * NZ + ZC_X + ch] = (bf16)f2bf(P * ge); *gp = (bf16)f2bf(hl * ge); } }
        __syncthreads();
    }
    if (!SAMPLE) { float* cs = F.CSUM() + ((size_t)(b * 32 + c) * 512 + ch) * 2; cs[0] = P; cs[1] = hl; }
}
__device__ __forceinline__ void rglru_fix_unit(Frame& F, int l, int b, int c) {
    const int ch = opaque_tid(F); float carry = 0.f;
    {   f32x2 cs[31];
#pragma unroll
        for (int j = 0; j < 31; ++j) cs[j] = (j < c) ? *(const f32x2*)(F.CSUM() + ((size_t)(b * 32 + j) * 512 + ch) * 2) : (f32x2){1.f, 0.f};
#pragma unroll
        for (int j = 0; j < 31; ++j) carry = cs[j][0] * carry + cs[j][1]; }
    const size_t t0 = (size_t)b * SEQ + 64 * c;
#pragma unroll 1
    for (int tb = 0; tb < 64; tb += 16) { float a1[16], a2[16];
#pragma unroll
        for (int t = 0; t < 16; ++t) { const bf16* p = F.Z() + (t0 + tb + t) * NZ; a1[t] = bf2f(p[ZC_X + ch]); a2[t] = bf2f(p[ZC_G + ch]); }
#pragma unroll
        for (int t = 0; t < 16; ++t) F.Z()[(t0 + tb + t) * NZ + ZC_G + ch] = (bf16)f2bf(a1[t] * carry + a2[t]); }
    if (c == 31 && (F.omask & OM_C_H)) { const float* cs = F.CSUM() + ((size_t)(b * 32 + 31) * 512 + ch) * 2; (F.p_c_h() + (size_t)(l * NB + b) * 512)[ch] = cs[0] * carry + cs[1]; }
}
typedef short bf16x4s __attribute__((ext_vector_type(4)));
__device__ __forceinline__ f32x4 mfma16(bf16x4s a, bf16x4s b, f32x4 c) { return __builtin_amdgcn_mfma_f32_16x16x16bf16_1k(a, b, c, 0, 0, 0); }
__device__ __forceinline__ bf16x4s cvt4(const f32x4 a) { const v2u w = {pg8::cvt_pk_bf16(a[0], a[1]), pg8::cvt_pk_bf16(a[2], a[3])}; return __builtin_bit_cast(bf16x4s, w); }
constexpr int RC_ABUF = 0, RC_RF = 16896, RC_KRAW = 25088, RC_VF = 33280, RC_LOR = 41472, RC_LW = 66048, RC_PV = 74240, RC_PG = 82432, RC_PR = 90624, RC_PK = 98816,
              RC_AH = 107008, RC_BH = 111616, RC_KH = 116224, RC_RH = 120832, RC_AHT = 125440, RC_BTT = 129536, RC_KTT = 133632, RC_VT = 137728, RC_GC = 141824, RC_RN = 142336, RC_OB = 142464, RC_PREV = 150656, RC_MU = 154240;
__device__ __forceinline__ f32x4 add_eye(f32x4 x, int fq, int fr) {
#pragma unroll
    for (int r = 0; r < 4; ++r) x[r] += (4 * fq + r == fr) ? 1.f : 0.f;
    return x; }
__device__ __forceinline__ void rwkv_chain_chunked(Frame& F, int l, int b, int h) {
    const int tid = opaque_tid(F), lane0 = tid & 63, wv = __builtin_amdgcn_readfirstlane(tid >> 6);
#define RC_LANE() int lane = lane0; asm volatile("" : "+v"(lane)); const int fq = lane >> 4, fr = lane & 15; (void)fq; (void)fr
    const int hc = h * 64 + lane0;
    LAS unsigned char* L = F.lds;
    LAS bf16* abuf = (LAS bf16*)(L + RC_ABUF); LAS float* rf = (LAS float*)(L + RC_RF); LAS float* kraw = (LAS float*)(L + RC_KRAW); LAS float* vf = (LAS float*)(L + RC_VF);
    LAS float* lor = (LAS float*)(L + RC_LOR); LAS float* LW = (LAS float*)(L + RC_LW); LAS float* PV = (LAS float*)(L + RC_PV); LAS float* PG = (LAS float*)(L + RC_PG);
    LAS float* PR = (LAS float*)(L + RC_PR); LAS float* PK = (LAS float*)(L + RC_PK); LAS float* RN = (LAS float*)(L + RC_RN);
    LAS bf16* AH = (LAS bf16*)(L + RC_AH); LAS bf16* BH = (LAS bf16*)(L + RC_BH); LAS bf16* KH = (LAS bf16*)(L + RC_KH); LAS bf16* RH = (LAS bf16*)(L + RC_RH);
    LAS bf16* AHT = (LAS bf16*)(L + RC_AHT); LAS bf16* BTT = (LAS bf16*)(L + RC_BTT); LAS bf16* KTT = (LAS bf16*)(L + RC_KTT); LAS bf16* VT = (LAS bf16*)(L + RC_VT); LAS float* GC = (LAS float*)(L + RC_GC);
    LAS float* OB = (LAS float*)(L + RC_OB); LAS float* prevb = (LAS float*)(L + RC_PREV); LAS float* muL = (LAS float*)(L + RC_MU);
    const float* mu = F.in[14] + (size_t)l * 1792; const float* w_up = F.in[16] + (size_t)l * 64 * 512; const float* a_up = F.in[18] + (size_t)l * 64 * 512; const float* g_up = F.in[19] + (size_t)l * 128 * 512;
    const float w0c = (F.in[15] + l * 512)[hc], a0c = (F.in[17] + l * 512)[hc], kkc = (F.in[20] + l * 512)[hc], kac = (F.in[21] + l * 512)[hc];
    const float* k_k = F.in[20] + l * 512; const float* r_k = F.in[22] + l * 512; const float* ln_w = F.in[23] + l * 512; const float* ln_b = F.in[24] + l * 512;
    const size_t row0 = (size_t)b * SEQ;
    const int nt = wv & 3, half = wv >> 2;
    bf16x8 Bq[4];
    { RC_LANE(); const int hcB = h * 64 + nt * 16 + fr;
    if (half == 0) {
#pragma unroll
        for (int ks = 0; ks < 2; ++ks)
#pragma unroll
            for (int j = 0; j < 8; ++j) { const int k = 32 * ks + 8 * fq + j; Bq[ks][j] = (short)f2bf(w_up[(size_t)k * 512 + hcB]); Bq[2 + ks][j] = (short)f2bf(a_up[(size_t)k * 512 + hcB]); }
    } else {
#pragma unroll
        for (int ks = 0; ks < 4; ++ks)
#pragma unroll
            for (int j = 0; j < 8; ++j) { const int k = 32 * ks + 8 * fq + j; Bq[ks][j] = (short)f2bf(g_up[(size_t)k * 512 + hcB]); }
    } }
    f32x4 ST[4];
#pragma unroll
    for (int kt = 0; kt < 4; ++kt) ST[kt] = (f32x4){0.f, 0.f, 0.f, 0.f};
    for (int c = tid; c < 896; c += NTHR) prevb[c] = 0.f;
    const int t2 = tid - 256, e1i = (t2 >> 4) & 15, lq = t2 & 15;
    v2u cq[14], pq[14]; f32x4 kk4r = {0.f, 0.f, 0.f, 0.f};
#define RC_ZCOLJ(j) (((j) < 3) ? (ZB_R + (j) * 512 + h * 64 + 4 * lq) : (ZB_XW + ((j) - 3) * 64 + 4 * lq))
#define RC_PREFETCH(t0) do { if (wv >= 4) { _Pragma("unroll") for (int s2 = 0; s2 < 2; ++s2) _Pragma("unroll") for (int j = 0; j < 7; ++j) { const int zc = RC_ZCOLJ(j), i = 16 * s2 + e1i; \
        cq[7 * s2 + j] = *(const v2u*)(F.Z() + (row0 + (t0) + i) * NZ + zc); pq[7 * s2 + j] = *(const v2u*)(F.Z() + (row0 + (t0) + (i > 0 ? i - 1 : 0)) * NZ + zc); } } } while (0)
#define RC_E1(pb) do { if (wv >= 4) { _Pragma("unroll") for (int s2 = 0; s2 < 2; ++s2) _Pragma("unroll") for (int j = 0; j < 7; ++j) { const int cc = 64 * j + 4 * lq, i = 16 * s2 + e1i; \
        const v2u cw = cq[7 * s2 + j], pw2 = pq[7 * s2 + j]; \
        float cur[4] = {bflo(cw.x), bfhi(cw.x), bflo(cw.y), bfhi(cw.y)}, prv[4] = {bflo(pw2.x), bfhi(pw2.x), bflo(pw2.y), bfhi(pw2.y)}; \
        if (s2 == 0) { const f32x4 pl = *(const LAS f32x4*)(prevb + (pb) * 448 + cc); if (e1i == 0) { prv[0] = pl[0]; prv[1] = pl[1]; prv[2] = pl[2]; prv[3] = pl[3]; } } \
        if (s2 == 1) { if (e1i == 15) *(LAS f32x4*)(prevb + ((pb) ^ 1) * 448 + cc) = (f32x4){cur[0], cur[1], cur[2], cur[3]}; } \
        const f32x4 m4 = *(const LAS f32x4*)(muL + cc); float zs[4]; _Pragma("unroll") for (int e = 0; e < 4; ++e) zs[e] = cur[e] + (prv[e] - cur[e]) * m4[e]; \
        if (j < 3) { LAS float* d = (j == 0 ? rf : (j == 1 ? kraw : vf)) + i * 64 + 4 * lq; *(LAS f32x4*)d = (f32x4){zs[0], zs[1], zs[2], zs[3]}; \
            if (j == 1) { const f32x4 kk4 = kk4r; float ss = (zs[0] * kk4[0]) * (zs[0] * kk4[0]) + (zs[1] * kk4[1]) * (zs[1] * kk4[1]) + (zs[2] * kk4[2]) * (zs[2] * kk4[2]) + (zs[3] * kk4[3]) * (zs[3] * kk4[3]); \
                ss = sum16(ss); if (lq == 0) RN[i] = __builtin_amdgcn_rsqf(ss + EPS); } } \
        else { float t4[4]; _Pragma("unroll") for (int e = 0; e < 4; ++e) t4[e] = (j == 3) ? ftanh(zs[e]) : ((j == 4) ? zs[e] : fsigmoid(zs[e])); \
            v2u w; w.x = pk2(t4[0], t4[1]); w.y = pk2(t4[2], t4[3]); *(LAS v2u*)(abuf + i * 264 + (j - 3) * 64 + 4 * lq) = w; } } } } while (0)
    const int pc0 = (tid & 15) * 4;
    const f32x4 p_rk = *(const f32x4*)(r_k + h * 64 + pc0), p_lw = *(const f32x4*)(ln_w + h * 64 + pc0), p_lb = *(const f32x4*)(ln_b + h * 64 + pc0);
#define RC_POST(tp) do { int tq = tid; asm volatile("" : "+v"(tq)); const int t = tq >> 4, c0 = (tq & 15) * 4; \
        f32x4 o4 = *(const LAS f32x4*)(OB + t * 64 + c0); const f32x4 r4 = *(const LAS f32x4*)(PR + t * 64 + c0), k4 = *(const LAS f32x4*)(PK + t * 64 + c0), v4 = *(const LAS f32x4*)(PV + t * 64 + c0), g4 = *(const LAS f32x4*)(PG + t * 64 + c0); \
        const float bs = sum16((r4[0] * k4[0] * p_rk[0] + r4[1] * k4[1] * p_rk[1]) + (r4[2] * k4[2] * p_rk[2] + r4[3] * k4[3] * p_rk[3])); \
        const float mean = sum16((o4[0] + o4[1]) + (o4[2] + o4[3])) * (1.f / 64.f); o4 = o4 - mean; \
        const float rstd = __builtin_amdgcn_rsqf(sum16((o4[0] * o4[0] + o4[1] * o4[1]) + (o4[2] * o4[2] + o4[3] * o4[3])) * (1.f / 64.f) + B_LN_EPS); \
        const f32x4 y = (o4 * rstd * p_lw + p_lb + v4 * bs) * g4; \
        v2u w; w.x = pk2(y[0], y[1]); w.y = pk2(y[2], y[3]); *(v2u*)(F.Z() + (row0 + (tp) + t) * NZ + ZB_R + h * 64 + c0) = w; } while (0)
    for (int c = tid; c < 448; c += NTHR) muL[c] = mu[((c < 192) ? ((c >> 6) * 512 + h * 64 + (c & 63)) : (1536 + (c - 192)))];
    if (wv >= 4) kk4r = *(const f32x4*)(k_k + h * 64 + 4 * lq);
    __syncthreads();
    RC_PREFETCH(0);
    RC_E1(0);
    __syncthreads();
    int pb = 1;
    for (int t0 = 0; t0 < SEQ; t0 += 32) {
        if (t0 > 0) RC_POST(t0 - 32);
        if (t0 + 32 < SEQ) RC_PREFETCH(t0 + 32);
        {   RC_LANE();
#pragma unroll
            for (int mt = 0; mt < 2; ++mt) { const LAS bf16* arow = abuf + (16 * mt + fr) * 264 + 8 * fq;
                if (half == 0) { f32x4 aw = {0.f, 0.f, 0.f, 0.f}, aa = aw;
#pragma unroll
                    for (int ks = 0; ks < 2; ++ks) { aw = __builtin_amdgcn_mfma_f32_16x16x32_bf16(*(const LAS bf16x8*)(arow + 32 * ks), Bq[ks], aw, 0, 0, 0);
                        aa = __builtin_amdgcn_mfma_f32_16x16x32_bf16(*(const LAS bf16x8*)(arow + 64 + 32 * ks), Bq[2 + ks], aa, 0, 0, 0); }
#pragma unroll
                    for (int r = 0; r < 4; ++r) { const int tok = 16 * mt + 4 * fq + r, n = nt * 16 + fr; lor[(tok * 3 + 0) * 64 + n] = aw[r]; lor[(tok * 3 + 1) * 64 + n] = aa[r]; }
                } else { f32x4 ag = {0.f, 0.f, 0.f, 0.f};
#pragma unroll
                    for (int ks = 0; ks < 4; ++ks) ag = __builtin_amdgcn_mfma_f32_16x16x32_bf16(*(const LAS bf16x8*)(arow + 128 + 32 * ks), Bq[ks], ag, 0, 0, 0);
#pragma unroll
                    for (int r = 0; r < 4; ++r) { const int tok = 16 * mt + 4 * fq + r, n = nt * 16 + fr; lor[(tok * 3 + 2) * 64 + n] = ag[r]; } } }
        }
        __syncthreads();
        float e_lw[4], e_a[4], e_kn[4], e_kp[4], e_r[4];
        { RC_LANE();
#pragma unroll
        for (int u = 0; u < 4; ++u) { const int t = 4 * wv + u;
            const float wl = lor[(t * 3 + 0) * 64 + lane], al = lor[(t * 3 + 1) * 64 + lane], gl = lor[(t * 3 + 2) * 64 + lane];
            const float wlog = -fsoftplus(-(w0c + wl)) - 0.5f; e_lw[u] = -fexp(wlog);
            e_a[u] = fsigmoid(a0c + al); const float kr = kraw[t * 64 + lane];
            e_kn[u] = kr * kkc * RN[t]; e_kp[u] = kr * (1.f + (e_a[u] - 1.f) * kac); e_r[u] = rf[t * 64 + lane];
            LW[t * 64 + lane] = e_lw[u]; PG[t * 64 + lane] = gl; PV[t * 64 + lane] = vf[t * 64 + lane]; PR[t * 64 + lane] = e_r[u]; PK[t * 64 + lane] = e_kp[u]; } }
        __syncthreads();
        {   RC_LANE(); const int sub = wv >> 2, tl0 = 4 * (wv & 3); float cum = 0.f, cumA[4] = {0.f, 0.f, 0.f, 0.f};
#pragma unroll
            for (int i = 0; i < 16; ++i) { cum += LW[(16 * sub + i) * 64 + lane];
#pragma unroll
                for (int u = 0; u < 4; ++u) if (i == tl0 + u) cumA[u] = cum; }
            const float cumC = cum;
#pragma unroll
            for (int u = 0; u < 4; ++u) { const int t = 4 * wv + u, tl = tl0 + u; const float ct = cumA[u];
                const float gm = fexp(ct - e_lw[u]), gi = fexp(-ct), gt = fexp(ct), gr = fexp(cumC - ct);
                const float ah = -e_kn[u] * gm, bh = e_kn[u] * e_a[u] * gi, kh = e_kp[u] * gi, rh = e_r[u] * gt, bt = e_kn[u] * e_a[u] * gr, kt = e_kp[u] * gr;
                AH[t * 72 + lane] = (bf16)f2bf(ah); BH[t * 72 + lane] = (bf16)f2bf(bh); KH[t * 72 + lane] = (bf16)f2bf(kh); RH[t * 72 + lane] = (bf16)f2bf(rh);
                AHT[sub * 1024 + lane * 16 + tl] = (bf16)f2bf(ah); BTT[sub * 1024 + lane * 16 + tl] = (bf16)f2bf(bt); KTT[sub * 1024 + lane * 16 + tl] = (bf16)f2bf(kt); VT[sub * 1024 + lane * 16 + tl] = (bf16)f2bf(PV[t * 64 + lane]); }
            if ((wv & 3) == 0) GC[sub * 64 + lane] = fexp(cumC);
        }
        __syncthreads();
        if (wv < 4 && !(F.omask & (1 << 22))) { RC_LANE(); const int e = wv;
#pragma unroll 1
          for (int sub = 0; sub < 2; ++sub) {
            const LAS bf16* AHs = AH + 16 * sub * 72; const LAS bf16* BHs = BH + 16 * sub * 72; const LAS bf16* KHs = KH + 16 * sub * 72; const LAS bf16* RHs = RH + 16 * sub * 72;
            const LAS bf16* AHTs = AHT + sub * 1024; const LAS bf16* BTTs = BTT + sub * 1024; const LAS bf16* KTTs = KTT + sub * 1024; const LAS bf16* VTs = VT + sub * 1024;
            bf16x8 fa[2], fb[2], fk[2], fr8[2];
#pragma unroll
            for (int ks = 0; ks < 2; ++ks) { fa[ks] = *(const LAS bf16x8*)(AHs + fr * 72 + 32 * ks + 8 * fq); fb[ks] = *(const LAS bf16x8*)(BHs + fr * 72 + 32 * ks + 8 * fq);
                fk[ks] = *(const LAS bf16x8*)(KHs + fr * 72 + 32 * ks + 8 * fq); fr8[ks] = *(const LAS bf16x8*)(RHs + fr * 72 + 32 * ks + 8 * fq); }
            const f32x4 z4 = {0.f, 0.f, 0.f, 0.f};
            f32x4 N = z4, NT = z4, Nak = z4, Nrb = z4, Nrk = z4;
#pragma unroll
            for (int ks = 0; ks < 2; ++ks) { N = __builtin_amdgcn_mfma_f32_16x16x32_bf16(fb[ks], fa[ks], N, 0, 0, 0); NT = __builtin_amdgcn_mfma_f32_16x16x32_bf16(fa[ks], fb[ks], NT, 0, 0, 0);
                Nak = __builtin_amdgcn_mfma_f32_16x16x32_bf16(fk[ks], fa[ks], Nak, 0, 0, 0); Nrb = __builtin_amdgcn_mfma_f32_16x16x32_bf16(fb[ks], fr8[ks], Nrb, 0, 0, 0);
                Nrk = __builtin_amdgcn_mfma_f32_16x16x32_bf16(fk[ks], fr8[ks], Nrk, 0, 0, 0); }
#pragma unroll
            for (int r = 0; r < 4; ++r) { const int rw = 4 * fq + r; if (!(rw < fr)) { N[r] = 0.f; Nak[r] = 0.f; } if (!(rw > fr)) NT[r] = 0.f; if (!(rw <= fr)) { Nrb[r] = 0.f; Nrk[r] = 0.f; } }
            const bf16x4s n_ = cvt4(N), nt_ = cvt4(NT);
            const f32x4 N2 = mfma16(nt_, n_, z4), N2T = mfma16(n_, nt_, z4);
            const bf16x4s n2_ = cvt4(N2), n2t_ = cvt4(N2T);
            const f32x4 N4 = mfma16(n2t_, n2_, z4), N4T = mfma16(n2_, n2t_, z4);
            const f32x4 N8 = mfma16(cvt4(N4T), cvt4(N4), z4);
            const f32x4 UT = mfma16(cvt4(add_eye(N2, fq, fr)), cvt4(add_eye(NT, fq, fr)), z4);
            const f32x4 WT = mfma16(cvt4(add_eye(N4, fq, fr)), cvt4(UT), z4);
            const f32x4 T = mfma16(cvt4(WT), cvt4(add_eye(N8, fq, fr)), z4);
            const bf16x4s t_ = cvt4(T);
            bf16x4s p1[4];
#pragma unroll
            for (int kt = 0; kt < 4; ++kt) p1[kt] = cvt4(mfma16(*(const LAS bf16x4s*)(AHTs + (16 * kt + fr) * 16 + 4 * fq), t_, z4));
            const bf16x4s vtf = *(const LAS bf16x4s*)(VTs + (16 * e + fr) * 16 + 4 * fq);
            const f32x4 nakv = mfma16(cvt4(Nak), vtf, z4);
            f32x4 sa = mfma16(t_, cvt4(nakv), z4);
            f32x4 o = mfma16(cvt4(Nrk), vtf, z4);
            bf16x4s sb[4];
#pragma unroll
            for (int kt = 0; kt < 4; ++kt) sb[kt] = cvt4(ST[kt]);
#pragma unroll
            for (int kt = 0; kt < 4; ++kt) { sa = mfma16(p1[kt], sb[kt], sa); o = mfma16(*(const LAS bf16x4s*)(RHs + fr * 72 + 16 * kt + 4 * fq), sb[kt], o); }
            const bf16x4s sab = cvt4(sa);
            o = mfma16(cvt4(Nrb), sab, o);
#pragma unroll
            for (int r = 0; r < 4; ++r) OB[(16 * sub + 4 * fq + r) * 64 + 16 * e + fr] = o[r];
#pragma unroll
            for (int kt = 0; kt < 4; ++kt) { const f32x4 g4 = *(const LAS f32x4*)(GC + 64 * sub + 16 * kt + 4 * fq); f32x4 a = ST[kt] * g4;
                a = mfma16(*(const LAS bf16x4s*)(BTTs + (16 * kt + fr) * 16 + 4 * fq), sab, a); a = mfma16(*(const LAS bf16x4s*)(KTTs + (16 * kt + fr) * 16 + 4 * fq), vtf, a); ST[kt] = a; }
          }
        } else if (t0 + 32 < SEQ && wv >= 4 && !(F.omask & (1 << 23))) { RC_E1(pb); }
        __syncthreads();
        pb ^= 1;
    }
    RC_POST(SEQ - 32);
    if ((F.omask & OM_B_S) && wv < 4) { RC_LANE(); float* o = F.p_b_S() + ((size_t)(l * NB + b) * 8 + h) * 4096;
#pragma unroll
        for (int kt = 0; kt < 4; ++kt) *(f32x4*)(o + (size_t)(16 * wv + fr) * 64 + 16 * kt + 4 * fq) = ST[kt]; }
    __syncthreads();
#undef RC_ZCOLJ
#undef RC_LANE
#undef RC_PREFETCH
#undef RC_E1
#undef RC_POST
}
template <int KIND>
__device__ __forceinline__ void small_gemm(Frame& F, const bf16* A, int lda, const bf16* Bt, int N, int K, const float* xold, float* ssq_out) {
    const int tid = opaque_tid(F), lane = tid & 63, wv = __builtin_amdgcn_readfirstlane(tid >> 6), fq = lane >> 4, fr = lane & 15;
    LAS float* part = (LAS float*)F.lds;
    const int ntiles = 8 * (N / 64), kw = K / 8, nks = kw / 32;
    const int erow = tid >> 3, ec8 = (tid & 7) * 8;
    for (int tile = F.bid; tile < ntiles; tile += F.G) {
        const int rb = tile & 7, cb = tile >> 3; const int row0 = MP + 64 * rb, col0 = 64 * cb;
        float m8[8];
#pragma unroll
        for (int j = 0; j < 8; ++j) m8[j] = 0.f;
        constexpr int NB_ = (KIND == 1) ? 3 : 1;
#pragma unroll 1
        for (int br = 0; br < NB_; ++br) {
            const bf16* Ab = A + (size_t)(row0 + fr) * lda + wv * kw + 8 * fq + ((KIND == 1) ? (br == 0 ? ZA_G : (br == 1 ? ZB_R : ZC_G)) : 0);
            const bf16* Bb = Bt + (size_t)(KIND == 1 ? br * 1024 : 0) * K + (size_t)(col0 + fr) * K + wv * kw + 8 * fq;
            f32x4 acc[4][4];
#pragma unroll
            for (int m = 0; m < 4; ++m)
#pragma unroll
                for (int n = 0; n < 4; ++n) acc[m][n] = (f32x4){0.f, 0.f, 0.f, 0.f};
            bf16x8 a[4], b[4];
#pragma unroll
            for (int u = 0; u < 4; ++u) { a[u] = *(const bf16x8*)(Ab + (size_t)16 * u * lda); b[u] = *(const bf16x8*)(Bb + (size_t)16 * u * K); }
            for (int ks = 1; ks < nks; ++ks) {
                bf16x8 na[4], nb[4];
#pragma unroll
                for (int u = 0; u < 4; ++u) { na[u] = *(const bf16x8*)(Ab + (size_t)16 * u * lda + 32 * ks); nb[u] = *(const bf16x8*)(Bb + (size_t)16 * u * K + 32 * ks); }
#pragma unroll
                for (int m = 0; m < 4; ++m)
#pragma unroll
                    for (int n = 0; n < 4; ++n) acc[m][n] = __builtin_amdgcn_mfma_f32_16x16x32_bf16(a[m], b[n], acc[m][n], 0, 0, 0);
#pragma unroll
                for (int u = 0; u < 4; ++u) { a[u] = na[u]; b[u] = nb[u]; }
            }
#pragma unroll
            for (int m = 0; m < 4; ++m)
#pragma unroll
                for (int n = 0; n < 4; ++n) acc[m][n] = __builtin_amdgcn_mfma_f32_16x16x32_bf16(a[m], b[n], acc[m][n], 0, 0, 0);
#pragma unroll
            for (int m = 0; m < 4; ++m)
#pragma unroll
                for (int n = 0; n < 4; ++n)
#pragma unroll
                    for (int r = 0; r < 4; ++r) part[wv * 4096 + (16 * m + 4 * fq + r) * 64 + 16 * n + fr] = acc[m][n][r];
            __syncthreads();
            float v[8];
#pragma unroll
            for (int j = 0; j < 8; ++j) v[j] = 0.f;
#pragma unroll
            for (int w = 0; w < 8; ++w) { const f32x4 p0 = *(const LAS f32x4*)(part + w * 4096 + erow * 64 + ec8), p1 = *(const LAS f32x4*)(part + w * 4096 + erow * 64 + ec8 + 4);
                v[0] += p0[0]; v[1] += p0[1]; v[2] += p0[2]; v[3] += p0[3]; v[4] += p1[0]; v[5] += p1[1]; v[6] += p1[2]; v[7] += p1[3]; }
            if (KIND == 1) { const int col = col0 + ec8; const v4u gw = *(const v4u*)(F.Z() + (size_t)(row0 + erow) * NZ + pg8::gate_col(br * 4 + (col >> 8)) + (col & 255));
                m8[0] += bflo(gw.x) * v[0]; m8[1] += bfhi(gw.x) * v[1]; m8[2] += bflo(gw.y) * v[2]; m8[3] += bfhi(gw.y) * v[3];
                m8[4] += bflo(gw.z) * v[4]; m8[5] += bfhi(gw.z) * v[5]; m8[6] += bflo(gw.w) * v[6]; m8[7] += bfhi(gw.w) * v[7]; }
            else {
#pragma unroll
                for (int j = 0; j < 8; ++j) m8[j] = v[j]; }
            __syncthreads();
        }
        const int row = row0 + erow, col = col0 + ec8;
        if (KIND == 0 || KIND == 3) { const float rs = pg8::row_rstd(F.SSQ(), row); float o[8];
#pragma unroll
            for (int j = 0; j < 8; ++j) { float x = m8[j] * rs; if (KIND == 0) x = fsigmoid(x); else { x = fmaxf(x, 0.f); x = x * x; } o[j] = x; }
            v4u w; w.x = pg8::cvt_pk_bf16(o[0], o[1]); w.y = pg8::cvt_pk_bf16(o[2], o[3]); w.z = pg8::cvt_pk_bf16(o[4], o[5]); w.w = pg8::cvt_pk_bf16(o[6], o[7]);
            if (KIND == 0) *(v4u*)(F.Z() + (size_t)row * NZ + pg8::gate_col(col >> 8) + (col & 255)) = w; else *(v4u*)(F.Z() + (size_t)row * DFF + col) = w;
        } else if (KIND == 1) {
            v4u w; w.x = pg8::cvt_pk_bf16(m8[0], m8[1]); w.y = pg8::cvt_pk_bf16(m8[2], m8[3]); w.z = pg8::cvt_pk_bf16(m8[4], m8[5]); w.w = pg8::cvt_pk_bf16(m8[6], m8[7]);
            *(v4u*)(F.Mb() + (size_t)row * D + col) = w;
        } else {
            const f32x4* xo = (const f32x4*)(xold + (size_t)(row - MP) * D + col); const f32x4 x0 = xo[0] + (f32x4){m8[0], m8[1], m8[2], m8[3]}, x1 = xo[1] + (f32x4){m8[4], m8[5], m8[6], m8[7]};
            f32x4* yo = (f32x4*)(F.y_x() + (size_t)row * D + col); yo[0] = x0; yo[1] = x1;
            v4u w; w.x = pg8::cvt_pk_bf16(x0[0], x0[1]); w.y = pg8::cvt_pk_bf16(x0[2], x0[3]); w.z = pg8::cvt_pk_bf16(x1[0], x1[1]); w.w = pg8::cvt_pk_bf16(x1[2], x1[3]);
            *(v4u*)(F.XB() + (size_t)row * D + col) = w;
            float ss = (x0[0] * x0[0] + x0[1] * x0[1]) + (x0[2] * x0[2] + x0[3] * x0[3]) + (x1[0] * x1[0] + x1[1] * x1[1]) + (x1[2] * x1[2] + x1[3] * x1[3]);
            ss = sum8(ss); if ((tid & 7) == 0) ssq_out[(size_t)row * 16 + cb] = ss;
        }
    }
}
struct Args { const float* in[38]; float* out; unsigned char* ws; int ph_lo, ph_hi, omask, pad; };
constexpr int PH_PER_LAYER = 10, PH_FINAL = 2 * PH_PER_LAYER, PH_END = PH_FINAL + 1;
constexpr int CW_BAR = 4096;

__global__ void __launch_bounds__(NTHR, 2) hybrid_fwd(Args args) {
    extern __shared__ __attribute__((aligned(16))) unsigned char lds_raw[];
    Frame F;
    F.lds = (LAS unsigned char*)lds_raw;
    F.tid = threadIdx.x; F.lane = F.tid & 63; F.wave = __builtin_amdgcn_readfirstlane(F.tid >> 6);
    F.G = gridDim.x; F.bid = blockIdx.x; F.omask = args.omask;
    static_assert(offsetof(Args, out) == 304 && offsetof(Args, ws) == 312, "kernarg layout used by LAUNDER");
    { const CAS unsigned char* _kp = (const CAS unsigned char*)__builtin_amdgcn_kernarg_segment_ptr(); F.in = (const float* const CAS*)_kp; F.out = args.out; F.ws = args.ws; }
    unsigned char* ws = args.ws;
    volatile LAS unsigned* MISC = (volatile LAS unsigned*)(F.lds + MISC_OFF);
    if (F.tid < 64) MISC[F.tid] = 0u;
    __syncthreads();
    { const unsigned xcc = xb_xcc_id(); if (threadIdx.x == 0) { (void)xb_add(&((unsigned*)(ws + WS_CTL) + CW_BAR)[XB_XCNT(xcc)], 1u);
        if (F.G <= 64 || F.bid >= 64) (void)xb_add(&((unsigned*)(ws + WS_CTL) + CW_BAR + XCD_BAR_WORDS)[XB_XCNT(xcc)], 1u);
        if (F.G > 128 && F.bid >= 96) (void)xb_add(&((unsigned*)(ws + WS_CTL) + CW_BAR + 2 * XCD_BAR_WORDS)[XB_XCNT(xcc)], 1u); } }
    const int lo = args.ph_lo, hi = args.ph_hi;
    const int G = F.G, bid = F.bid;

#define LAUNDER() do { int _t = threadIdx.x; asm volatile("" : "+v"(_t)); F.tid = _t; F.lane = _t & 63; F.wave = __builtin_amdgcn_readfirstlane(_t >> 6); \
        const CAS unsigned char* _kp = (const CAS unsigned char*)__builtin_amdgcn_kernarg_segment_ptr(); asm volatile("" : "+s"(_kp)); \
        F.in = (const float* const CAS*)_kp; F.out = *(float* const CAS*)(_kp + 304); F.ws = *(unsigned char* const CAS*)(_kp + 312); } while (0)
#define MAIN_BAR() do { XcdBarrier _b; _b.bar = (unsigned*)(args.ws + WS_CTL) + CW_BAR; _b.x = xb_xcc_id(); _b.st = (volatile LAS unsigned*)(F.lds + MISC_OFF) + 8; _b.nparts = (unsigned)G; xcd_barrier(_b); } while (0)
#define PHASE_BEGIN(p) if (lo <= (p) && (p) < hi && !((args.omask & 512) && ((p) % 10 >= 2 && (p) % 10 <= 4)) && !((args.omask & 1024) && (p) % 10 == 1)) { if ((p) > lo) MAIN_BAR(); LAUNDER();
#define PHASE_END }
    if (args.omask & (1 << 24)) { for (int i = 0; i < 16; ++i) MAIN_BAR(); }
    for (int l = 0; l < 2; ++l) {
        const int p0 = l * PH_PER_LAYER;
        PHASE_BEGIN(p0 + 0) p0_weights(F, l); if (l == 0) p0_xb(F); PHASE_END
        PHASE_BEGIN(p0 + 1)
            pg8::Gemm g{F.XB(), D, F.WIN(), D}; pg8::Order S; S.init(MROWS, NZ, G, bid, 1, (size_t)256 * D * 2, (size_t)256 * D * 2);
            pg8::EpiRowScale<0> E{F.Z(), NZ, F.SSQ(), F.lds};
            pg8::gemm_phase<pg8::EpiRowScale<0>, pg8::Order, true, true>(F.lds, g, S, E);
        PHASE_END
        PHASE_BEGIN(p0 + 2) p2_misc(F, l); PHASE_END
        PHASE_BEGIN(p0 + 3)
            if (bid < 64 && !(args.omask & 2048)) { const int b = bid >> 3, h = bid & 7;
                rwkv_chain_chunked(F, l, b, h); }
            const bool few = (G <= 64); const bool in_sub = few || bid >= 64; const int me = few ? bid : bid - 64, np = few ? G : G - 64;
            if (in_sub) {
#define SUB_BAR() do { XcdBarrier barB; barB.bar = (unsigned*)(F.ws + WS_CTL) + CW_BAR + XCD_BAR_WORDS; barB.x = xb_xcc_id(); barB.st = (volatile LAS unsigned*)(F.lds + MISC_OFF) + 10; barB.nparts = (unsigned)np; xcd_barrier(barB); LAUNDER(); } while (0)
                const int skip = (args.omask >> 13) & 15; const bool do_items = !(args.omask & 4096), do_p2 = (lo <= p0 + 4 && p0 + 4 < hi && !(args.omask & (1 << 20)));
                constexpr int N_AP = NB * 32 * 4, N_CP = NB * 32, N_CS = 8, N_GS = NSB * 4, N_RS = NSB * 8;
                if (do_items && !(skip & 1)) for (int it = me; it < N_AP; it += np) gdn_prep_unit(F, l, it >> 7, (it >> 2) & 31, it & 3);
                SUB_BAR();
                const int nscan = (np > 64) ? 32 : 0;
                if (me < nscan) { if (do_p2) gdn_scan_unit(F, l, me >> 2, me & 3); }
                else if (do_items) { for (int it = me - nscan; it < N_CP + N_CS + N_GS + N_RS; it += np - nscan) { int r = it;
                    if (r < N_CP) { if (!(skip & 2)) rglru_prep_unit<false>(F, l, r >> 5, r & 31); continue; } r -= N_CP;
                    if (r < N_CS) { if (!(skip & 2)) rglru_prep_unit<true>(F, l, r, 0); continue; } r -= N_CS;
                    if (r < N_GS) { if (!(skip & 4)) gdn_sample_unit(F, l, r >> 2, r & 3); continue; } r -= N_GS;
                    if (!(skip & 8)) { const int sb = r >> 3, h = r & 7;
                      rwkv_unit(F, l, MP + sb * TS, TS, h, F.in[4] + (((size_t)l * NSB + sb) * 8 + h) * 4096, F.in[5] + ((size_t)l * NSB + sb) * 1792, F.s_b_S() + (((size_t)l * NSB + sb) * 8 + h) * 4096); } } }
                if (nscan == 0) { if (do_p2) for (int it = me; it < 32; it += np) gdn_scan_unit(F, l, it >> 2, it & 3);
                    SUB_BAR();
                    if (do_p2) for (int it = me; it < NB * 32; it += np) rglru_fix_unit(F, l, it >> 5, it & 31); }
                else if (me >= nscan) {
                    { XcdBarrier barC; barC.bar = (unsigned*)(F.ws + WS_CTL) + CW_BAR + 2 * XCD_BAR_WORDS; barC.x = xb_xcc_id(); barC.st = (volatile LAS unsigned*)(F.lds + MISC_OFF) + 12; barC.nparts = (unsigned)(np - nscan); xcd_barrier(barC); LAUNDER(); }
                    if (do_p2) for (int it = me - nscan; it < NB * 32; it += np - nscan) rglru_fix_unit(F, l, it >> 5, it & 31); }
#undef SUB_BAR
            }
        PHASE_END
        PHASE_BEGIN(p0 + 5)
            pg8::Gemm g{F.XB(), D, F.WIN() + (size_t)NZ * D, D}; pg8::Order S; S.init(MP, NGATE, G, bid, 1, (size_t)256 * D * 2, (size_t)256 * D * 2);
            pg8::EpiRowScale<1> E{F.Z(), NZ, F.SSQ(), F.lds};
            pg8::gemm_phase<pg8::EpiRowScale<1>, pg8::Order, true, true>(F.lds, g, S, E);
            small_gemm<0>(F, F.XB(), D, F.WIN() + (size_t)NZ * D, NGATE, D, nullptr, nullptr);
        PHASE_END
        PHASE_BEGIN(p0 + 6)
            static_assert(ZA_G * 2 == 3072 && ZB_R * 2 == 4096 && ZC_G * 2 == 8704, "branch A-operand column offsets are hard-wired in pg8::Order::next");
            pg8::Gemm g{F.Z(), NZ, F.WBR(), 512}; pg8::Order S; S.init(MP, D, G, bid, 3, (size_t)256 * NZ * 2, (size_t)256 * 512 * 2);
            pg8::EpiBranch E{F.Mb(), F.Z(), NZ};
            pg8::gemm_phase<pg8::EpiBranch, pg8::Order, true, true>(F.lds, g, S, E);
            small_gemm<1>(F, F.Z(), NZ, F.WBR(), D, 512, nullptr, nullptr);
        PHASE_END
        PHASE_BEGIN(p0 + 7)
            pg8::Gemm g{F.Mb(), D, F.WOUT(), D}; pg8::Order S; S.init(MP, D, G, bid, 1, (size_t)256 * D * 2, (size_t)256 * D * 2);
            pg8::EpiRes E{l == 0 ? F.in[0] : F.y_x(), l == 0 ? F.in[1] : F.y_x() + (size_t)MP * D, F.y_x(), F.XB(), F.SSQ()};
            pg8::gemm_phase<pg8::EpiRes, pg8::Order, true, true>(F.lds, g, S, E);
            small_gemm<2>(F, F.Mb(), D, F.WOUT(), D, D, l == 0 ? F.in[1] : F.y_x() + (size_t)MP * D, F.SSQ());
        PHASE_END
        PHASE_BEGIN(p0 + 8)
            pg8::Gemm g{F.XB(), D, F.WUP(), D}; pg8::Order S; S.init(MP, DFF, G, bid, 1, (size_t)256 * D * 2, (size_t)256 * D * 2);
            pg8::EpiRowScale<2> E{F.Z(), DFF, F.SSQ(), F.lds};
            pg8::gemm_phase<pg8::EpiRowScale<2>, pg8::Order, true, true>(F.lds, g, S, E);
            small_gemm<3>(F, F.XB(), D, F.WUP(), DFF, D, nullptr, nullptr);
        PHASE_END
        PHASE_BEGIN(p0 + 9)
            pg8::Gemm g{F.Z(), DFF, F.WDN(), DFF}; pg8::Order S; S.init(MP, D, G, bid, 1, (size_t)256 * DFF * 2, (size_t)256 * DFF * 2);
            pg8::EpiRes E{F.y_x(), F.y_x() + (size_t)MP * D, F.y_x(), F.XB(), F.SSQ()};
            pg8::gemm_phase<pg8::EpiRes, pg8::Order, true, true>(F.lds, g, S, E);
            small_gemm<2>(F, F.Z(), DFF, F.WDN(), D, DFF, F.y_x() + (size_t)MP * D, F.SSQ());
        PHASE_END
    }
    if (args.omask & 256) { MAIN_BAR(); LAUNDER();
        const int c0 = args.omask >> 16; const int gw = bid * NWAVES + F.wave, NGW = G * NWAVES;
        for (int m = gw; m < MROWS; m += NGW) { const bf16* src = (c0 == 9999) ? F.Mb() + (size_t)m * D : F.Z() + (size_t)m * NZ + c0; float* dst = F.y_x() + (size_t)m * D;
            for (int j = F.lane; j < D / 2; j += 64) { const unsigned w = ((const unsigned*)src)[j]; dst[2 * j] = bflo(w); dst[2 * j + 1] = bfhi(w); } }
    }
    if ((lo <= PH_FINAL && PH_FINAL < hi) || (args.omask & 128)) { MAIN_BAR(); LAUNDER();
        const float* fg = F.in[37]; const int gw = bid * NWAVES + F.wave, NGW = G * NWAVES;
        for (int m = gw; m < MROWS; m += NGW) { f32x4* xp = (f32x4*)(F.y_x() + (size_t)m * D) + F.lane * 4; f32x4 v[4]; float s = 0.f;
#pragma unroll
            for (int j = 0; j < 4; ++j) { v[j] = xp[j]; s += (v[j][0] * v[j][0] + v[j][1] * v[j][1]) + (v[j][2] * v[j][2] + v[j][3] * v[j][3]); }
            const float rs = __builtin_amdgcn_rsqf(wave_sum(s) * (1.f / D) + EPS);
#pragma unroll
            for (int j = 0; j < 4; ++j) { const f32x4 gg = ((const f32x4*)fg)[F.lane * 4 + j]; xp[j] = v[j] * rs * gg; } }
    PHASE_END
#undef LAUNDER
#undef MAIN_BAR
#undef PHASE_BEGIN
#undef PHASE_END
}

static int fast_launch(void* const* d_in, void* d_out, void* d_ws, size_t ws_size, hipStream_t stream, int ph_lo, int ph_hi, int omask) {
    static int grid = 0;
    if (grid == 0) {
        if (ws_size < WS_END) { fprintf(stderr, "kernel_launch: needs %zu bytes of workspace, got %zu\n", (size_t)WS_END, ws_size); grid = -1; return -1; }
        int dev = 0, cus = 0, per_cu = 0;
        if (hipGetDevice(&dev) != hipSuccess || hipDeviceGetAttribute(&cus, hipDeviceAttributeMultiprocessorCount, dev) != hipSuccess) { grid = -1; return -1; }
        if (hipFuncSetAttribute((const void*)hybrid_fwd, hipFuncAttributeMaxDynamicSharedMemorySize, LDS_BYTES) != hipSuccess) { fprintf(stderr, "kernel_launch: hipFuncSetAttribute failed\n"); grid = -1; return -1; }
        if (hipOccupancyMaxActiveBlocksPerMultiprocessor(&per_cu, (const void*)hybrid_fwd, NTHR, LDS_BYTES) != hipSuccess || per_cu < 1) fprintf(stderr, "kernel_launch: occupancy query says %d blocks per CU\n", per_cu);
        (void)hipGetLastError();
        grid = cus;
        fprintf(stderr, "kernel_launch: grid %d, ws %zu\n", grid, ws_size);
    }
    if (grid < 0) return -1;
    if (hipMemsetAsync((char*)d_ws + WS_CTL, 0, CTL_ZERO_BYTES, stream) != hipSuccess) return -1;
    Args a{};
    for (int i = 0; i < 38; ++i) a.in[i] = (const float*)d_in[i];
    a.out = (float*)d_out; a.ws = (unsigned char*)d_ws; a.ph_lo = ph_lo; a.ph_hi = ph_hi; a.omask = omask; a.pad = 0;
    hipLaunchKernelGGL(hybrid_fwd, dim3(grid), dim3(NTHR), LDS_BYTES, stream, a);
    return 0;
}
extern "C" void kernel_launch(void* const* d_in, const int* in_sizes, int n_in, void* d_out, int out_size, void* d_ws, size_t ws_size, hipStream_t stream) {
    fast_launch(d_in, d_out, d_ws, ws_size, stream, 0, 21, 127);
}
```

```cpp
#include <hip/hip_runtime.h>
#include <cstdio>
#include <cstdint>
#include <cstddef>
#define GAS __attribute__((address_space(1)))
#define LAS __attribute__((address_space(3)))
#define CAS __attribute__((address_space(4)))
typedef unsigned short bf16;
typedef unsigned v4u __attribute__((ext_vector_type(4)));
typedef unsigned v2u __attribute__((ext_vector_type(2)));
typedef float f32x4 __attribute__((ext_vector_type(4)));
typedef float f32x2 __attribute__((ext_vector_type(2)));
typedef short bf16x8 __attribute__((ext_vector_type(8)));
typedef short bf16x4 __attribute__((ext_vector_type(4)));

constexpr int NWAVES = 8, NTHR = 512;
constexpr int D = 1024, DFF = 4096, MP = 16384, MS = 512, MROWS = MP + MS;
constexpr int SEQ = 2048, NB = 8, NSB = 128, TS = 4;
constexpr int NIN_SRC = 7944;
constexpr int NZ = 4864;
constexpr int ZA_Q = 0, ZA_K = 512, ZA_V = 1024, ZA_G = 1536, ZB_R = 2048, ZB_K = 2560, ZB_V = 3072, ZB_XW = 3584, ZB_XA = 3648, ZB_XG = 3712, ZC_X = 3840, ZC_G = 4352;
constexpr int NGATE = 3072, NWIN = NZ + NGATE;
constexpr float EPS = 1e-6f, B_LN_EPS = 64e-5f;

constexpr size_t MiB = 1u << 20;
constexpr size_t WS_CTL = 0, CTL_ZERO_BYTES = 1 * MiB;
constexpr size_t WS_WIN = 1 * MiB, WS_WBR = 17 * MiB, WS_WOUT = 20 * MiB, WS_WUP = 22 * MiB, WS_WDN = 30 * MiB, WS_MISCW = 38 * MiB;
constexpr size_t WS_XB = 39 * MiB, WS_SSQ = 72 * MiB, WS_BG = 74 * MiB, WS_HALO = 75 * MiB, WS_CSUM = 79 * MiB, WS_GL = 80 * MiB, WS_GW = 81 * MiB, WS_GATT = 97 * MiB;
constexpr size_t WS_M = 105 * MiB, WS_Z = 138 * MiB, WS_END = 295 * MiB;
static_assert(WS_Z + (size_t)MROWS * NZ * 2 <= WS_END && (size_t)MROWS * DFF * 2 <= (size_t)MROWS * NZ * 2, "ws map");
constexpr size_t MW_WSP = 0;
constexpr size_t MW_WCA = 64 * 1024;
constexpr size_t MW_WCX = 128 * 1024;
constexpr size_t HALO_A_OFF = 0;
constexpr size_t HALO_C_OFF = 3 * MiB;

constexpr int LDS_BYTES = 163840;
constexpr int MISC_OFF = LDS_BYTES - 256;

#define RLX_AGENT __ATOMIC_RELAXED, __HIP_MEMORY_SCOPE_AGENT
#define LDS_WAIT() asm volatile("s_waitcnt lgkmcnt(0)" ::: "memory")
#define VM_WAIT() asm volatile("s_waitcnt vmcnt(0)" ::: "memory")

typedef __bf16 bf16x2_t __attribute__((ext_vector_type(2)));
__device__ __forceinline__ unsigned pk2(float lo, float hi) { const f32x2 v = {lo, hi}; return __builtin_bit_cast(unsigned, __builtin_convertvector(v, bf16x2_t)); }
__device__ __forceinline__ unsigned f2bf(float f) { return pk2(f, 0.f) & 0xffffu; }
__device__ __forceinline__ float bf2f(unsigned short b) { return __builtin_bit_cast(float, ((unsigned)b) << 16); }
__device__ __forceinline__ float bflo(unsigned w) { return __builtin_bit_cast(float, w << 16); }
__device__ __forceinline__ float bfhi(unsigned w) { return __builtin_bit_cast(float, w & 0xffff0000u); }
__device__ __forceinline__ float fexp(float x) { return __expf(x); }
__device__ __forceinline__ float fsigmoid(float x) { return __builtin_amdgcn_rcpf(1.f + __expf(-x)); }
__device__ __forceinline__ float fsoftplus(float x) { return fmaxf(x, 0.f) + __logf(1.f + __expf(-fabsf(x))); }
__device__ __forceinline__ float fsilu(float x) { return x * fsigmoid(x); }
__device__ __forceinline__ float ftanh(float x) { const float e = __expf(2.f * x); return 1.f - 2.f * __builtin_amdgcn_rcpf(e + 1.f); }
__device__ __forceinline__ float fgelu(float x) { return 0.5f * x * (1.f + ftanh(0.7978845608028654f * (x + 0.044715f * x * x * x))); }
template <int CTRL> __device__ __forceinline__ float dppf(float x) { return __builtin_bit_cast(float, __builtin_amdgcn_mov_dpp(__builtin_bit_cast(int, x), CTRL, 0xf, 0xf, true)); }
__device__ __forceinline__ float sum8(float x) {
    x += dppf<0xB1>(x); x += dppf<0x4E>(x); x += dppf<0x141>(x); return x; }
__device__ __forceinline__ float sum16(float x) {
    x += dppf<0xB1>(x); x += dppf<0x4E>(x); x += dppf<0x141>(x); x += dppf<0x140>(x); return x; }
__device__ __forceinline__ float xor16f(float x) { return __builtin_bit_cast(float, __builtin_amdgcn_ds_swizzle(__builtin_bit_cast(int, x), 0x401F)); }
__device__ __forceinline__ float add_xor32(float x) {
    const auto r = __builtin_amdgcn_permlane32_swap(__builtin_bit_cast(unsigned, x), __builtin_bit_cast(unsigned, x), false, false);
    return __builtin_bit_cast(float, (unsigned)r[0]) + __builtin_bit_cast(float, (unsigned)r[1]); }
__device__ __forceinline__ float wave_sum(float v) { v = sum16(v); v += xor16f(v); return add_xor32(v); }
namespace pg8 {
#define PG8_LAS __attribute__((address_space(3)))
typedef unsigned short bf16_t;
constexpr int BM = 256, BK = 64, HALF = 128, HTB = HALF * BK * 2, STAGE_BYTES = 8 * HTB, NXCD = 8, WGM = 8;

__host__ __device__ __forceinline__ int lds_byte(int r, int c) { const int st = (r >> 4) * 2 + (c >> 5), rr = r & 15, cc = c & 31, ob = rr * 64 + cc * 2; return st * 1024 + (ob ^ (((ob >> 9) & 1) << 5)); }
__host__ __device__ __forceinline__ void stage_rc(int b, int& R, int& C) { const int st = b / 1024, sb = b % 1024, swz = sb ^ (((sb >> 9) & 1) << 5); R = (st >> 1) * 16 + swz / 64; C = (st & 1) * 32 + (swz % 64) / 2; }
__host__ __device__ __forceinline__ int perm32(int rho) { const int n = rho >> 4, i = rho & 15; return 8 * (i >> 2) + 4 * n + (i & 3); }

struct Unit { int pm, pn, aux; size_t a_off, b_off; };
struct Gemm { const bf16_t* A; int lda; const bf16_t* Bt; int K; };

struct Order {
    int nM, nN, nwg, G, c, rep;
    size_t a_tile, b_tile;
    __device__ __forceinline__ void init(int M, int N, int G_, int c_, int rep_, size_t a_tile_, size_t b_tile_) {
        nM = M / BM; nN = N / BM; nwg = nM * nN; G = G_; c = c_; rep = rep_; a_tile = a_tile_; b_tile = b_tile_;
        }
    __device__ __forceinline__ bool next(int i, Unit& u) const {
        int t = i, sub = i; if (rep == 3) { t = i / 3; sub = i - 3 * t; }
        const long L = (long)t * G + c; if (L >= nwg) return false;
        int wgid = (int)L; { const int q = nwg / NXCD, r = nwg % NXCD, xcd = wgid % NXCD, off = wgid / NXCD; wgid = (xcd < r ? xcd * (q + 1) : r * (q + 1) + (xcd - r) * q) + off; }
        const int nig = WGM * nN, gid = wgid / nig, fm = gid * WGM, gsz = (nM - fm) < WGM ? (nM - fm) : WGM;
        u.pm = fm + ((wgid % nig) % gsz); u.pn = (wgid % nig) / gsz; u.aux = sub;
        u.a_off = (size_t)u.pm * a_tile; u.b_off = (size_t)u.pn * b_tile;
        if (rep == 3) {
            u.a_off += (size_t)(3072 + 1024 * sub + (sub >> 1) * 3584); u.b_off += (size_t)sub * (1024 * 512 * 2); }
        return true;
    }
    __device__ __forceinline__ void a_ready(const Unit&) const {}
    __device__ __forceinline__ void done(const Unit&) const {}
};

__device__ __forceinline__ int gate_col(int t) { return t < 4 ? 256 * t : (t < 8 ? 2560 + 256 * (t - 4) : (t < 10 ? 1024 + 256 * (t - 8) : 3840 + 256 * (t - 10))); }
__device__ __forceinline__ unsigned cvt_pk_bf16(float lo, float hi) { const f32x2 v = {lo, hi}; return __builtin_bit_cast(unsigned, __builtin_convertvector(v, bf16x2_t)); }

__device__ __forceinline__ float row_rstd(const float* ssq, int row) {
    const f32x4* p = (const f32x4*)(ssq + (size_t)row * 16); const f32x4 a = p[0], b = p[1], c = p[2], d = p[3];
    const float s = ((a[0] + a[1]) + (a[2] + a[3])) + ((b[0] + b[1]) + (b[2] + b[3])) + ((c[0] + c[1]) + (c[2] + c[3])) + ((d[0] + d[1]) + (d[2] + d[3]));
    return __builtin_amdgcn_rsqf(s * (1.0f / 1024.0f) + 1e-6f);
}
template <int ACT> struct EpiRowScale {
    static constexpr bool PERM = true, AFTER_DRAIN = false, PREP = true;
    bf16_t* O; int ldc; const float* ssq;
    template <class Sched> __device__ __forceinline__ void prepare(PG8_LAS unsigned char* lds, const Sched& S, int tid) const {
        PG8_LAS float* tab = (PG8_LAS float*)(lds + STAGE_BYTES); Unit u;
        for (int i = 0; i < 8 && S.next(i, u); ++i) if (tid < 256) tab[i * 256 + tid] = row_rstd(ssq, u.pm * BM + tid);
        __syncthreads();
    }
    PG8_LAS unsigned char* ldsE;
    __device__ __forceinline__ void operator()(const f32x4 (&acc)[2][2][4][2], const Unit& u, int wr, int wc, int fr, int fq) const {
        const int row0 = u.pm * BM + wr * 64 + fr;
        int colt = u.pn * BM; if (ACT == 1) colt = gate_col(u.pn);
        const int col0 = colt + wc * 32 + 8 * fq;
#pragma unroll
        for (int ai = 0; ai < 2; ++ai)
#pragma unroll
            for (int m = 0; m < 4; ++m) { const int row = row0 + ai * HALF + m * 16; const float rs = ((const PG8_LAS float*)(ldsE + STAGE_BYTES))[u.aux * 256 + (row & 255)];
                bf16_t* rowp = O + (size_t)row * ldc + col0;
#pragma unroll
                for (int bj = 0; bj < 2; ++bj) { f32x4 v0 = acc[ai][bj][m][0] * rs, v1 = acc[ai][bj][m][1] * rs;
                    if (ACT == 1) {
#pragma unroll
                        for (int j = 0; j < 4; ++j) { v0[j] = __builtin_amdgcn_rcpf(1.f + __expf(-v0[j])); v1[j] = __builtin_amdgcn_rcpf(1.f + __expf(-v1[j])); } }
                    if (ACT == 2) {
#pragma unroll
                        for (int j = 0; j < 4; ++j) { const float a = fmaxf(v0[j], 0.f), b = fmaxf(v1[j], 0.f); v0[j] = a * a; v1[j] = b * b; } }
                    v4u w; w.x = cvt_pk_bf16(v0[0], v0[1]); w.y = cvt_pk_bf16(v0[2], v0[3]); w.z = cvt_pk_bf16(v1[0], v1[1]); w.w = cvt_pk_bf16(v1[2], v1[3]);
                    *(v4u*)(rowp + bj * HALF) = w; } }
    }
};
struct EpiBranch {
    static constexpr bool PERM = true, AFTER_DRAIN = false, PREP = false;
    bf16_t* Mb; const bf16_t* Zg; int ldz;
    __device__ __forceinline__ void operator()(const f32x4 (&acc)[2][2][4][2], const Unit& u, int wr, int wc, int fr, int fq) const {
        const int row0 = u.pm * BM + wr * 64 + fr; const int b = u.aux;
        const int col0 = u.pn * BM + wc * 32 + 8 * fq, g0 = gate_col(b * 4 + u.pn) + wc * 32 + 8 * fq;
#pragma unroll
        for (int ai = 0; ai < 2; ++ai)
#pragma unroll
            for (int m = 0; m < 4; ++m) { const int row = row0 + ai * HALF + m * 16;
                bf16_t* mp = Mb + (size_t)row * 1024 + col0; const bf16_t* gp = Zg + (size_t)row * ldz + g0;
                v4u gw2[2], ow2[2];
#pragma unroll
                for (int bj = 0; bj < 2; ++bj) { gw2[bj] = *(const v4u*)(gp + bj * HALF); if (b != 0) ow2[bj] = *(const v4u*)(mp + bj * HALF); }
#pragma unroll
                for (int bj = 0; bj < 2; ++bj) { const v4u gw = gw2[bj];
                    f32x4 v0 = acc[ai][bj][m][0], v1 = acc[ai][bj][m][1];
                    v0[0] *= bflo(gw.x); v0[1] *= bfhi(gw.x); v0[2] *= bflo(gw.y); v0[3] *= bfhi(gw.y);
                    v1[0] *= bflo(gw.z); v1[1] *= bfhi(gw.z); v1[2] *= bflo(gw.w); v1[3] *= bfhi(gw.w);
                    if (b != 0) { const v4u ow = ow2[bj];
                        v0[0] += bflo(ow.x); v0[1] += bfhi(ow.x); v0[2] += bflo(ow.y); v0[3] += bfhi(ow.y);
                        v1[0] += bflo(ow.z); v1[1] += bfhi(ow.z); v1[2] += bflo(ow.w); v1[3] += bfhi(ow.w); }
                    v4u w; w.x = cvt_pk_bf16(v0[0], v0[1]); w.y = cvt_pk_bf16(v0[2], v0[3]); w.z = cvt_pk_bf16(v1[0], v1[1]); w.w = cvt_pk_bf16(v1[2], v1[3]);
                    *(v4u*)(mp + bj * HALF) = w; }
                if (m & 1) asm volatile("" ::: "memory"); }
    }
};
struct EpiRes {
    static constexpr bool PERM = false, AFTER_DRAIN = false, PREP = false;
    const float* xp; const float* xs; float* out; bf16_t* xb; float* ssq;
    __device__ __forceinline__ void operator()(const f32x4 (&acc)[2][2][4][2], const Unit& u, int wr, int wc, int fr, int fq) const {
        const int row0 = u.pm * BM + wr * 64 + fr, col0 = u.pn * BM + wc * 32 + 4 * fq;
        const float* base = (u.pm < 64) ? xp + (size_t)row0 * 1024 : xs + (size_t)(row0 - 16384) * 1024;
#pragma unroll
        for (int ai = 0; ai < 2; ++ai)
#pragma unroll
            for (int m = 0; m < 4; ++m) { const size_t roff = (size_t)(ai * HALF + m * 16) * 1024 + col0; const int row = row0 + ai * HALF + m * 16;
                float ss = 0.f;
#pragma unroll
                for (int bj = 0; bj < 2; ++bj)
#pragma unroll
                    for (int n = 0; n < 2; ++n) { const f32x4 bs = *(const f32x4*)(base + roff + bj * HALF + n * 16); const f32x4 o = bs + acc[ai][bj][m][n];
                        *(f32x4*)(out + (size_t)row * 1024 + col0 + bj * HALF + n * 16) = o;
                        v2u w; w.x = cvt_pk_bf16(o[0], o[1]); w.y = cvt_pk_bf16(o[2], o[3]);
                        *(v2u*)(xb + (size_t)row * 1024 + col0 + bj * HALF + n * 16) = w;
                        ss += (o[0] * o[0] + o[1] * o[1]) + (o[2] * o[2] + o[3] * o[3]); }
                ss += xor16f(ss); ss = add_xor32(ss);
                if (fq == 0) ssq[(size_t)row * 16 + u.pn * 4 + wc] = ss;
                asm volatile("" ::: "memory"); }
    }
};

template <class Epi, class Sched, bool ALIGN_EPI = false, bool SP2 = false>
__device__ __forceinline__ void gemm_phase(PG8_LAS unsigned char* lds, const Gemm g, const Sched& S, const Epi& E) {
    int tid = threadIdx.x; asm volatile("" : "+v"(tid));
    const int wid = __builtin_amdgcn_readfirstlane(tid >> 6), lane = tid & 63, wr = wid >> 2, wc = wid & 3, fr = lane & 15, fq = lane >> 4;
    const int K = g.K, nt = K / BK, lda = g.lda;
    unsigned voffA[2], voffB[2];
#pragma unroll
    for (int i = 0; i < 2; ++i) { int R, C; stage_rc(tid * 16 + i * 8192, R, C); const int Rb = Epi::PERM ? ((R & ~31) + perm32(R & 31)) : R;
        voffA[i] = (unsigned)(R * lda + C) * 2u; voffB[i] = (unsigned)(Rb * K + C) * 2u; }
    const size_t kstep = (size_t)(BK * 2);
    const size_t hstepA = (size_t)HALF * lda * 2, hstepB = (size_t)HALF * K * 2;
    const unsigned ldsw = (unsigned)wid * 1024u;
    const int aoff = lds_byte(wr * 64 + fr, fq * 8), boff = lds_byte(wc * 32 + fr, fq * 8);
#define PG8_SA(b, h) (((b) * 2 + (h)) * HTB)
#define PG8_SB(b, h) ((4 + (b) * 2 + (h)) * HTB)
#define PG8_STAGE(bufoff, gbase, voff) do { _Pragma("unroll") for (int _i = 0; _i < 2; ++_i) \
        __builtin_amdgcn_global_load_lds((const unsigned*)((const char*)(gbase) + (voff)[_i]), (PG8_LAS unsigned*)(lds + (bufoff) + ldsw + _i * 8192), 16, 0, 0); } while (0)
#define PG8_LDA(dst, b, h) do { _Pragma("unroll") for (int m = 0; m < 4; ++m) _Pragma("unroll") for (int k = 0; k < 2; ++k) dst[m][k] = *(const PG8_LAS bf16x8*)(lds + PG8_SA(b, h) + aoff + m * 2048 + k * 1024); } while (0)
#define PG8_LDB(dst, b, h) do { _Pragma("unroll") for (int n = 0; n < 2; ++n) _Pragma("unroll") for (int k = 0; k < 2; ++k) dst[n][k] = *(const PG8_LAS bf16x8*)(lds + PG8_SB(b, h) + boff + n * 2048 + k * 1024); } while (0)
#define PG8_MMA(ai, bj, At, Bt) do { __builtin_amdgcn_s_setprio(1); _Pragma("unroll") for (int m = 0; m < 4; ++m) _Pragma("unroll") for (int n = 0; n < 2; ++n) _Pragma("unroll") for (int k = 0; k < 2; ++k) \
        acc[ai][bj][m][n] = __builtin_amdgcn_mfma_f32_16x16x32_bf16(Bt[n][k], At[m][k], acc[ai][bj][m][n], 0, 0, 0); __builtin_amdgcn_s_setprio(0); } while (0)
#define PG8_WAIT_V(n) asm volatile("s_waitcnt vmcnt(" #n ")" ::: "memory")
#define PG8_WAIT_L(n) asm volatile("s_waitcnt lgkmcnt(" #n ")" ::: "memory")
#define PG8_BAR __builtin_amdgcn_s_barrier()
#define PG8_SCHED __builtin_amdgcn_sched_barrier(0)
    if constexpr (Epi::PREP) E.prepare(lds, S, tid);
    Unit cur, nxt; int ui = 0;
    if (!S.next(0, cur)) return;
    f32x4 acc[2][2][4][2];
#pragma unroll
    for (int a = 0; a < 2; ++a)
#pragma unroll
        for (int b = 0; b < 2; ++b)
#pragma unroll
            for (int m = 0; m < 4; ++m)
#pragma unroll
                for (int n = 0; n < 2; ++n) acc[a][b][m][n] = (f32x4){0.f, 0.f, 0.f, 0.f};
    bf16x8 At[4][2], B0[2][2], B1[2][2];
    const char* cA = (const char*)g.A + cur.a_off; const char* cB = (const char*)g.Bt + cur.b_off;
    S.a_ready(cur);
    if constexpr (SP2) {
        PG8_STAGE(PG8_SB(0, 0), cB, voffB); PG8_STAGE(PG8_SB(0, 1), cB + hstepB, voffB); PG8_STAGE(PG8_SA(0, 0), cA, voffA); PG8_STAGE(PG8_SA(0, 1), cA + hstepA, voffA);
        if (wr == 1) PG8_BAR;
        PG8_WAIT_V(2); PG8_BAR;
        PG8_STAGE(PG8_SB(1, 0), cB + kstep, voffB); PG8_STAGE(PG8_SA(1, 0), cA + kstep, voffA); PG8_STAGE(PG8_SB(1, 1), cB + hstepB + kstep, voffB);
        PG8_WAIT_V(6); PG8_BAR;
    } else {
        PG8_STAGE(PG8_SB(0, 0), cB, voffB); PG8_STAGE(PG8_SA(0, 0), cA, voffA); PG8_STAGE(PG8_SB(0, 1), cB + hstepB, voffB); PG8_STAGE(PG8_SA(0, 1), cA + hstepA, voffA);
        if (wr == 1) PG8_BAR;
        PG8_WAIT_V(4); PG8_BAR;
        PG8_STAGE(PG8_SB(1, 0), cB + kstep, voffB); PG8_STAGE(PG8_SA(1, 0), cA + kstep, voffA); PG8_STAGE(PG8_SB(1, 1), cB + hstepB + kstep, voffB);
        PG8_WAIT_V(6); PG8_BAR;
    }
    for (;;) {
        const bool has_next = S.next(ui + 1, nxt);
        const char* nA = has_next ? (const char*)g.A + nxt.a_off : cA; const char* nB = has_next ? (const char*)g.Bt + nxt.b_off : cB;
        for (int t = 0; t < nt; t += 2) {
            const bool last = (t == nt - 2);
            const char* a1 = cA + (size_t)(t + 1) * kstep;
            const char* a2 = last ? nA : cA + (size_t)(t + 2) * kstep; const char* b2 = last ? nB : cB + (size_t)(t + 2) * kstep;
            const char* a3 = a2 + kstep; const char* b3 = b2 + kstep;
            if (last && has_next) S.a_ready(nxt);
            if constexpr (SP2) {
            PG8_LDB(B0, 0, 0); PG8_LDB(B1, 0, 1); PG8_SCHED; PG8_LDA(At, 0, 0); PG8_STAGE(PG8_SA(1, 1), a1 + hstepA, voffA);
            PG8_WAIT_V(8); PG8_WAIT_L(0); PG8_BAR; PG8_MMA(0, 0, At, B0); PG8_MMA(0, 1, At, B1); PG8_BAR; PG8_SCHED;
            PG8_LDA(At, 0, 1); PG8_STAGE(PG8_SB(0, 0), b2, voffB); PG8_STAGE(PG8_SB(0, 1), b2 + hstepB, voffB); PG8_STAGE(PG8_SA(0, 0), a2, voffA);
            PG8_WAIT_V(8); PG8_WAIT_L(0); PG8_BAR; PG8_MMA(1, 0, At, B0); PG8_MMA(1, 1, At, B1); PG8_BAR; PG8_SCHED;
            PG8_LDB(B0, 1, 0); PG8_LDB(B1, 1, 1); PG8_SCHED; PG8_LDA(At, 1, 0); PG8_STAGE(PG8_SA(0, 1), a2 + hstepA, voffA);
            PG8_WAIT_V(8); PG8_WAIT_L(0); PG8_BAR; PG8_MMA(0, 0, At, B0); PG8_MMA(0, 1, At, B1); PG8_BAR; PG8_SCHED;
            PG8_LDA(At, 1, 1); PG8_STAGE(PG8_SB(1, 0), b3, voffB); PG8_STAGE(PG8_SB(1, 1), b3 + hstepB, voffB); PG8_STAGE(PG8_SA(1, 0), a3, voffA);
            PG8_WAIT_V(8); PG8_WAIT_L(0); PG8_BAR; PG8_MMA(1, 0, At, B0); PG8_MMA(1, 1, At, B1); PG8_BAR; PG8_SCHED;
            } else {
            PG8_LDB(B0, 0, 0); PG8_SCHED; PG8_LDA(At, 0, 0); PG8_STAGE(PG8_SA(1, 1), a1 + hstepA, voffA);
            PG8_WAIT_L(8); PG8_BAR; PG8_WAIT_L(0); PG8_MMA(0, 0, At, B0); PG8_BAR; PG8_SCHED;
            PG8_LDB(B1, 0, 1); PG8_STAGE(PG8_SB(0, 0), b2, voffB);
            PG8_BAR; PG8_WAIT_L(0); PG8_MMA(0, 1, At, B1); PG8_BAR;
            PG8_LDA(At, 0, 1); PG8_STAGE(PG8_SA(0, 0), a2, voffA);
            PG8_BAR; PG8_WAIT_L(0); PG8_MMA(1, 0, At, B0); PG8_BAR; PG8_SCHED;
            PG8_STAGE(PG8_SB(0, 1), b2 + hstepB, voffB);
            PG8_WAIT_V(6); PG8_BAR; PG8_MMA(1, 1, At, B1); PG8_BAR;
            PG8_LDB(B0, 1, 0); PG8_SCHED; PG8_LDA(At, 1, 0); PG8_STAGE(PG8_SA(0, 1), a2 + hstepA, voffA);
            PG8_WAIT_L(8); PG8_BAR; PG8_WAIT_L(0); PG8_MMA(0, 0, At, B0); PG8_BAR; PG8_SCHED;
            PG8_LDB(B1, 1, 1); PG8_STAGE(PG8_SB(1, 0), b3, voffB);
            PG8_BAR; PG8_WAIT_L(0); PG8_MMA(0, 1, At, B1); PG8_BAR;
            PG8_LDA(At, 1, 1); PG8_STAGE(PG8_SA(1, 0), a3, voffA);
            PG8_BAR; PG8_WAIT_L(0); PG8_MMA(1, 0, At, B0); PG8_BAR; PG8_SCHED;
            PG8_STAGE(PG8_SB(1, 1), b3 + hstepB, voffB);
            PG8_WAIT_V(6); PG8_BAR; PG8_MMA(1, 1, At, B1); PG8_BAR;
            }
        }
        if constexpr (ALIGN_EPI) { if (wr == 0) PG8_BAR; }
        if constexpr (!Epi::AFTER_DRAIN) { E(acc, cur, wr, wc, fr, fq); S.done(cur); }
        if (!has_next) break;
#pragma unroll
        for (int a = 0; a < 2; ++a)
#pragma unroll
            for (int b = 0; b < 2; ++b)
#pragma unroll
                for (int m = 0; m < 4; ++m)
#pragma unroll
                    for (int n = 0; n < 2; ++n) acc[a][b][m][n] = (f32x4){0.f, 0.f, 0.f, 0.f};
        cur = nxt; cA = nA; cB = nB; ++ui;
        if constexpr (ALIGN_EPI) { if (wr == 1) PG8_BAR; }
    }
    PG8_WAIT_V(0);
    if constexpr (!ALIGN_EPI) { if (wr == 0) PG8_BAR; }
    PG8_BAR;
#undef PG8_SA
#undef PG8_SB
#undef PG8_STAGE
#undef PG8_LDA
#undef PG8_LDB
#undef PG8_MMA
#undef PG8_WAIT_V
#undef PG8_WAIT_L
#undef PG8_BAR
#undef PG8_SCHED
}
}
typedef GAS unsigned gu32;
#define XB_TMO      128
#define XB_XCNT(j)  (256  + 64 * (j))
#define XB_XSUB(j)  (1280 + 64 * (j))
#define XB_XGEN(j)  (2304 + 64 * (j))
#define XB_TOP      3328
#define XB_TOPGEN   3392
#define XCD_BAR_WORDS 3456
#define XB_SPIN_CAP (1u << 20)

__device__ __forceinline__ unsigned xb_ld(unsigned* p)              { return __hip_atomic_load(p, __ATOMIC_RELAXED, __HIP_MEMORY_SCOPE_AGENT); }
__device__ __forceinline__ unsigned xb_add(unsigned* p, unsigned v) { return __hip_atomic_fetch_add(p, v, __ATOMIC_RELAXED, __HIP_MEMORY_SCOPE_AGENT); }
__device__ __forceinline__ unsigned xb_xcc_id() { return (unsigned)__builtin_amdgcn_s_getreg((3 << 11) | 20) & 0xFu; }
#define XB_SPIN(cond, bar) do { unsigned _sp = 0; while (cond) { __builtin_amdgcn_s_sleep(1); \
    if ((++_sp & 255u) == 0u) { if (xb_ld(&(bar)[XB_TMO])) break; if (_sp > XB_SPIN_CAP) { atomicAdd(&(bar)[XB_TMO], 1u); break; } } } } while (0)

struct XcdBarrier {
    unsigned* bar; unsigned x; unsigned nparts;
    volatile LAS unsigned* st;
};
__device__ __forceinline__ XcdBarrier xcd_barrier_post(unsigned* bar, volatile LAS unsigned* st, unsigned nparts) {
    XcdBarrier b; b.bar = bar; b.x = xb_xcc_id(); b.st = st; b.nparts = nparts;
    if (threadIdx.x == 0) (void)xb_add(&bar[XB_XCNT(b.x)], 1u);
    return b;
}
__device__ __forceinline__ void xcd_barrier_complete(unsigned* bar, unsigned x, unsigned G, unsigned& nloc, unsigned& nx) {
    unsigned sum, cnt, mine, sp = 0u;
    for (;;) {
        sum = 0u; cnt = 0u; mine = 0u;
#pragma unroll
        for (unsigned j = 0; j < 16; ++j) { const unsigned c = xb_ld(&bar[XB_XCNT(j)]); sum += c; cnt += (c > 0u) ? 1u : 0u; mine = (j == x) ? c : mine; }
        if (sum == G) break;
        __builtin_amdgcn_s_sleep(1);
        if ((++sp & 255u) == 0u) { if (xb_ld(&bar[XB_TMO])) break; if (sp > XB_SPIN_CAP) { atomicAdd(&bar[XB_TMO], 1u); break; } }
    }
    nloc = mine > 0u ? mine : 1u; nx = cnt > 0u ? cnt : 1u;
}
__device__ __forceinline__ void xcd_barrier(const XcdBarrier& b0) {
    asm volatile("s_waitcnt vmcnt(0)" ::: "memory");
    __syncthreads();
    if (threadIdx.x == 0) {
        XcdBarrier b = b0; { unsigned* p = b.bar; unsigned x = b.x; asm volatile("" : "+s"(p), "+s"(x)); b.bar = p; b.x = x; }
        unsigned* bar = b.bar;
        __builtin_amdgcn_s_waitcnt(0);
        unsigned nloc = b.st[0], nx = b.st[1];
        if (nloc == 0u) { xcd_barrier_complete(bar, b.x, b.nparts, nloc, nx); b.st[0] = nloc; b.st[1] = nx; }
        const unsigned old = xb_add(&bar[XB_XSUB(b.x)], 1u);
        const unsigned gen = old / nloc;
        if (old + 1u == (gen + 1u) * nloc) {
            __builtin_amdgcn_fence(__ATOMIC_RELEASE, "agent");
            asm volatile("s_waitcnt vmcnt(0)" ::: "memory");
            const unsigned og = xb_add(&bar[XB_TOP], 1u);
            const unsigned tg = og / nx;
            if (og + 1u == (tg + 1u) * nx) xb_add(&bar[XB_TOPGEN], 1u);
            else XB_SPIN(xb_ld(&bar[XB_TOPGEN]) == tg, bar);
            __builtin_amdgcn_fence(__ATOMIC_ACQUIRE, "agent");
            xb_add(&bar[XB_XGEN(b.x)], 1u);
            asm volatile("s_waitcnt vmcnt(0)" ::: "memory");
        } else {
            XB_SPIN(xb_ld(&bar[XB_XGEN(b.x)]) == gen, bar);
            __builtin_amdgcn_fence(__ATOMIC_ACQUIRE, "agent");
            asm volatile("s_waitcnt vmcnt(0)" ::: "memory");
        }
    }
    __syncthreads();
}
constexpr size_t O_YX = 0, O_PAS = O_YX + (size_t)MROWS * D, O_PAC = O_PAS + (size_t)2 * NB * 4 * 128 * 128, O_PBS = O_PAC + (size_t)2 * NB * 3 * 1536, O_PBH = O_PBS + (size_t)2 * NB * 8 * 64 * 64,
                 O_PCH = O_PBH + (size_t)2 * NB * 1792, O_PCC = O_PCH + (size_t)2 * NB * 512, O_SAS = O_PCC + (size_t)2 * NB * 3 * 512, O_SAC = O_SAS + (size_t)2 * NSB * 4 * 128 * 128,
                 O_SBS = O_SAC + (size_t)2 * NSB * 3 * 1536, O_SBH = O_SBS + (size_t)2 * NSB * 8 * 64 * 64, O_SCH = O_SBH + (size_t)2 * NSB * 1792, O_SCC = O_SCH + (size_t)2 * NSB * 512;
struct Frame {
    LAS unsigned char* lds;
    int tid, lane, wave, G, bid;
    const float* const CAS* in;
    float* out;
    unsigned char* ws;
    int omask;
#define FPTR(name, T, expr) __device__ __forceinline__ T* name() const { return (T*)(expr); }
    FPTR(y_x, float, out + O_YX) FPTR(p_a_S, float, out + O_PAS) FPTR(p_a_conv, float, out + O_PAC) FPTR(p_b_S, float, out + O_PBS) FPTR(p_b_shift, float, out + O_PBH) FPTR(p_c_h, float, out + O_PCH) FPTR(p_c_conv, float, out + O_PCC)
    FPTR(s_a_S, float, out + O_SAS) FPTR(s_a_conv, float, out + O_SAC) FPTR(s_b_S, float, out + O_SBS) FPTR(s_b_shift, float, out + O_SBH) FPTR(s_c_h, float, out + O_SCH) FPTR(s_c_conv, float, out + O_SCC)
    FPTR(WIN, bf16, ws + WS_WIN) FPTR(WBR, bf16, ws + WS_WBR) FPTR(WOUT, bf16, ws + WS_WOUT) FPTR(WUP, bf16, ws + WS_WUP) FPTR(WDN, bf16, ws + WS_WDN)
    FPTR(WSP, float, ws + WS_MISCW + MW_WSP) FPTR(WCA, bf16, ws + WS_MISCW + MW_WCA) FPTR(WCX, bf16, ws + WS_MISCW + MW_WCX)
    FPTR(XB, bf16, ws + WS_XB) FPTR(SSQ, float, ws + WS_SSQ) FPTR(BG, float, ws + WS_BG) FPTR(HALO_A, bf16, ws + WS_HALO + HALO_A_OFF) FPTR(HALO_C, bf16, ws + WS_HALO + HALO_C_OFF)
    FPTR(CSUM, float, ws + WS_CSUM) FPTR(GL, float, ws + WS_GL) FPTR(GW, bf16, ws + WS_GW) FPTR(GATT, bf16, ws + WS_GATT) FPTR(Mb, bf16, ws + WS_M) FPTR(Z, bf16, ws + WS_Z)
#undef FPTR
};
__device__ __forceinline__ int opaque_tid(const Frame& F) { int t = F.tid; asm volatile("" : "+v"(t)); return t; }
constexpr int OM_A_S = 1, OM_A_CONV = 2, OM_B_S = 4, OM_B_SHIFT = 8, OM_C_H = 16, OM_C_CONV = 32, OM_Y = 64, OM_ALL = 127;

__device__ __forceinline__ void tr_item(const float* W, int ldw, int src_col0, int k0, const float* kscale, bf16* WT, int ldt, int dst_row0, LAS float* scr, int lane) {
    float v[32];
    const float* src = W + (size_t)(k0 + (lane >> 5)) * ldw + src_col0 + (lane & 31);
#pragma unroll
    for (int i = 0; i < 32; ++i) v[i] = src[(size_t)2 * i * ldw];
    if (kscale) {
#pragma unroll
        for (int i = 0; i < 32; ++i) v[i] *= kscale[k0 + 2 * i + (lane >> 5)]; }
#pragma unroll
    for (int i = 0; i < 32; ++i) scr[(2 * i + (lane >> 5)) * 33 + (lane & 31)] = v[i];
    LDS_WAIT(); asm volatile("" ::: "memory");
    const int c = lane & 7;
#pragma unroll
    for (int j = 0; j < 4; ++j) { const int n = (lane >> 3) + 8 * j; const LAS float* s = scr + (8 * c) * 33 + n;
        v4u o; o.x = pk2(s[0], s[33]); o.y = pk2(s[66], s[99]); o.z = pk2(s[132], s[165]); o.w = pk2(s[198], s[231]);
        *(GAS v4u*)(WT + (size_t)(dst_row0 + n) * ldt + k0 + 8 * c) = o; }
    LDS_WAIT(); asm volatile("" ::: "memory");
}
__device__ __forceinline__ void p0_weights(Frame& F, int l) {
    LAS float* scr = (LAS float*)(F.lds + F.wave * 16384);
    const int gw = F.bid * NWAVES + F.wave, NGW = F.G * NWAVES;
    const float* w_in = F.in[9] + (size_t)l * D * NIN_SRC; const float* g1 = F.in[8] + (size_t)l * D;
    const float* w_br = F.in[32] + (size_t)l * 3 * 512 * D; const float* w_out = F.in[33] + (size_t)l * D * D; const float* g2 = F.in[34] + (size_t)l * D;
    const float* w_up = F.in[35] + (size_t)l * D * DFF; const float* w_dn = F.in[36] + (size_t)l * DFF * D;
    const float* c_wa = F.in[27] + (size_t)l * 8 * 64 * 64; const float* c_wx = F.in[29] + (size_t)l * 8 * 64 * 64;
    constexpr int I_IN = 16 * 248, I_BR = 3 * 8 * 32, I_OUT = 16 * 32, I_UP = 16 * 128, I_DN = 64 * 32, I_C = 32;
    constexpr int NITEMS = I_IN + I_BR + I_OUT + I_UP + I_DN + I_C;
    for (int it = gw; it < NITEMS; it += NGW) {
        int r = it;
        if (r < I_IN) { const int kb = r / 248, nb = r % 248, n0 = nb * 32; tr_item(w_in, NIN_SRC, n0 + (n0 >= 2048 ? 8 : 0), kb * 64, g1, F.WIN(), D, n0, scr, F.lane); continue; } r -= I_IN;
        if (r < I_BR) { const int b = r / 256, q = r % 256, kb = q / 32, nb = q % 32; tr_item(w_br + (size_t)b * 512 * D, D, nb * 32, kb * 64, nullptr, F.WBR() + (size_t)b * D * 512, 512, nb * 32, scr, F.lane); continue; } r -= I_BR;
        if (r < I_OUT) { const int kb = r / 32, nb = r % 32; tr_item(w_out, D, nb * 32, kb * 64, nullptr, F.WOUT(), D, nb * 32, scr, F.lane); continue; } r -= I_OUT;
        if (r < I_UP) { const int kb = r / 128, nb = r % 128; tr_item(w_up, DFF, nb * 32, kb * 64, g2, F.WUP(), D, nb * 32, scr, F.lane); continue; } r -= I_UP;
        if (r < I_DN) { const int kb = r / 32, nb = r % 32; tr_item(w_dn, D, nb * 32, kb * 64, nullptr, F.WDN(), DFF, nb * 32, scr, F.lane); continue; } r -= I_DN;
        { const int which = r / 16, q = r % 16, g = q / 2, nb = q % 2; tr_item((which ? c_wx : c_wa) + (size_t)g * 4096, 64, nb * 32, 0, nullptr, (which ? F.WCX() : F.WCA()) + (size_t)g * 4096, 64, nb * 32, scr, F.lane); }
    }
    for (int i = F.bid * NTHR + F.tid; i < 8 * 1024; i += F.G * NTHR) { const int j = i >> 10, k = i & 1023; F.WSP()[i] = w_in[(size_t)k * NIN_SRC + 2048 + j] * g1[k]; }
}
__device__ __forceinline__ void p0_xb(Frame& F) {
    const int gw = F.bid * NWAVES + F.wave, NGW = F.G * NWAVES;
    for (int m = gw; m < MROWS; m += NGW) {
        const float* xr = (m < MP) ? F.in[0] + (size_t)m * D : F.in[1] + (size_t)(m - MP) * D;
        const f32x4* xp = (const f32x4*)xr + F.lane * 4; float s = 0.f; v4u o0, o1;
        const f32x4 a = xp[0], b = xp[1], c = xp[2], d = xp[3];
        s = (a[0] * a[0] + a[1] * a[1] + a[2] * a[2] + a[3] * a[3]) + (b[0] * b[0] + b[1] * b[1] + b[2] * b[2] + b[3] * b[3]) + (c[0] * c[0] + c[1] * c[1] + c[2] * c[2] + c[3] * c[3]) + (d[0] * d[0] + d[1] * d[1] + d[2] * d[2] + d[3] * d[3]);
        o0.x = pk2(a[0], a[1]); o0.y = pk2(a[2], a[3]); o0.z = pk2(b[0], b[1]); o0.w = pk2(b[2], b[3]);
        o1.x = pk2(c[0], c[1]); o1.y = pk2(c[2], c[3]); o1.z = pk2(d[0], d[1]); o1.w = pk2(d[2], d[3]);
        v4u* dst = (v4u*)(F.XB() + (size_t)m * D) + F.lane * 2; dst[0] = o0; dst[1] = o1;
        s = wave_sum(s);
        if (F.lane < 16) F.SSQ()[(size_t)m * 16 + F.lane] = (F.lane == 0) ? s : 0.f;
    }
}

__device__ __forceinline__ void p2_misc(Frame& F, int l) {
    const int gw = F.bid * NWAVES + F.wave, NGW = F.G * NWAVES, lane = F.lane;
    const float* A_log = F.in[11] + l * 4; const float* dtb = F.in[12] + l * 4;
    {   float wsp[8][16];
#pragma unroll
        for (int j = 0; j < 8; ++j)
#pragma unroll
            for (int e = 0; e < 16; ++e) wsp[j][e] = F.WSP()[j * 1024 + lane * 16 + e];
        for (int m = gw; m < MROWS; m += NGW) {
            const v4u* xp = (const v4u*)(F.XB() + (size_t)m * D) + lane * 2; const v4u x0 = xp[0], x1 = xp[1];
            float xv[16] = {bflo(x0.x), bfhi(x0.x), bflo(x0.y), bfhi(x0.y), bflo(x0.z), bfhi(x0.z), bflo(x0.w), bfhi(x0.w), bflo(x1.x), bfhi(x1.x), bflo(x1.y), bfhi(x1.y), bflo(x1.z), bfhi(x1.z), bflo(x1.w), bfhi(x1.w)};
            const float rs = pg8::row_rstd(F.SSQ(), m);
            float mine = 0.f;
#pragma unroll
            for (int j = 0; j < 8; ++j) { float s = 0.f;
#pragma unroll
                for (int e = 0; e < 16; ++e) s += xv[e] * wsp[j][e];
                s = wave_sum(s) * rs; if (lane == j) mine = s; }
            if (lane < 4) F.BG()[(size_t)m * 8 + lane] = fsigmoid(mine);
            else if (lane < 8) F.BG()[(size_t)m * 8 + lane] = -fexp(A_log[lane - 4]) * fsoftplus(mine + dtb[lane - 4]);
        }
    }
    for (int it = gw; it < NB * 32 * 3; it += NGW) { const int i = it % 3, c = (it / 3) % 32 + 1, b = it / 96; const size_t row = (size_t)b * SEQ + 64 * c - 3 + i;
        const bf16* zr = F.Z() + row * NZ; bf16* ha = F.HALO_A() + ((size_t)(b * 33 + c) * 3 + i) * 1536; bf16* hc = F.HALO_C() + ((size_t)(b * 33 + c) * 3 + i) * 512;
        for (int q = lane; q < 192; q += 64) ((v4u*)ha)[q] = ((const v4u*)zr)[q];
        ((v4u*)hc)[lane] = ((const v4u*)(zr + ZC_X))[lane];
        if (c == 32) {
            if (F.omask & OM_A_CONV) { float* o = F.p_a_conv() + ((size_t)(l * NB + b) * 3 + i) * 1536; for (int q = lane; q < 1536; q += 64) o[q] = bf2f(zr[q]); }
            if (F.omask & OM_C_CONV) { float* o = F.p_c_conv() + ((size_t)(l * NB + b) * 3 + i) * 512; for (int q = lane; q < 512; q += 64) o[q] = bf2f(zr[ZC_X + q]); }
        } }
    if (F.omask & OM_B_SHIFT) for (int b = gw; b < NB; b += NGW) { const bf16* zr = F.Z() + ((size_t)b * SEQ + SEQ - 1) * NZ + ZB_R; float* o = F.p_b_shift() + (size_t)(l * NB + b) * 1792; for (int q = lane; q < 1792; q += 64) o[q] = bf2f(zr[q]); }
    for (int it = gw; it < NSB * 3; it += NGW) { const int i = it % 3, sb = it / 3; const bf16* zr = F.Z() + ((size_t)MP + sb * TS + 1 + i) * NZ;
        if (F.omask & OM_A_CONV) { float* o = F.s_a_conv() + ((size_t)(l * NSB + sb) * 3 + i) * 1536; for (int q = lane; q < 1536; q += 64) o[q] = bf2f(zr[q]); }
        if (F.omask & OM_C_CONV) { float* o = F.s_c_conv() + ((size_t)(l * NSB + sb) * 3 + i) * 512; for (int q = lane; q < 512; q += 64) o[q] = bf2f(zr[ZC_X + q]); }
        if (i == 2 && (F.omask & OM_B_SHIFT)) { float* o = F.s_b_shift() + (size_t)(l * NSB + sb) * 1792; for (int q = lane; q < 1792; q += 64) o[q] = bf2f(zr[ZB_R + q]); } }
}

constexpr int RW_VEC = 0, RW_ABUF = 57344, RW_LOR = 74240, RW_KRAW = 98816, RW_OBUF = 107008, RW_PREV = 115200, RW_BON = 118784;
__device__ __forceinline__ void rwkv_unit(Frame& F, int l, int row0, int T, int h, const float* S0, const float* shift0, float* Sout) {
    const int tid = opaque_tid(F), lane = tid & 63, wv = __builtin_amdgcn_readfirstlane(tid >> 6);
    LAS float* vec = (LAS float*)(F.lds + RW_VEC); LAS bf16* abuf = (LAS bf16*)(F.lds + RW_ABUF); LAS float* lor = (LAS float*)(F.lds + RW_LOR);
    LAS float* kraw = (LAS float*)(F.lds + RW_KRAW); LAS float* obuf = (LAS float*)(F.lds + RW_OBUF); LAS float* prevb = (LAS float*)(F.lds + RW_PREV); LAS float* bon = (LAS float*)(F.lds + RW_BON);
    const float* mu = F.in[14] + (size_t)l * 1792; const float* w0 = F.in[15] + l * 512; const float* w_up = F.in[16] + (size_t)l * 64 * 512; const float* a0 = F.in[17] + l * 512;
    const float* a_up = F.in[18] + (size_t)l * 64 * 512; const float* g_up = F.in[19] + (size_t)l * 128 * 512; const float* k_k = F.in[20] + l * 512; const float* k_a = F.in[21] + l * 512;
    const float* r_k = F.in[22] + l * 512; const float* ln_w = F.in[23] + l * 512; const float* ln_b = F.in[24] + l * 512;
    const int mt = wv >> 2, nt = wv & 3, fq = lane >> 4, fr = lane & 15, hcB = h * 64 + nt * 16 + fr;
    bf16x8 Bw[2], Ba[2], Bg[4];
#pragma unroll
    for (int ks = 0; ks < 2; ++ks)
#pragma unroll
        for (int j = 0; j < 8; ++j) { const int k = 32 * ks + 8 * fq + j; Bw[ks][j] = (short)f2bf(w_up[(size_t)k * 512 + hcB]); Ba[ks][j] = (short)f2bf(a_up[(size_t)k * 512 + hcB]); }
#pragma unroll
    for (int ks = 0; ks < 4; ++ks)
#pragma unroll
        for (int j = 0; j < 8; ++j) { const int k = 32 * ks + 8 * fq + j; Bg[ks][j] = (short)f2bf(g_up[(size_t)k * 512 + hcB]); }
    const int sv = tid >> 3, sk0 = (tid & 7) * 8;
    float S[8];
#pragma unroll
    for (int j = 0; j < 8; ++j) S[j] = S0 ? S0[(size_t)sv * 64 + sk0 + j] : 0.f;
    for (int c = tid; c < 448; c += NTHR) { float p = 0.f;
        if (shift0) { const int zc = (c < 192) ? (ZB_R + (c >> 6) * 512 + h * 64 + (c & 63)) : (ZB_XW + (c - 192)); p = shift0[zc - ZB_R]; }
        prevb[c] = p; }
    __syncthreads();
    int pb = 0;
    for (int t0 = 0; t0 < T; t0 += 32) {
        const int CL = (T - t0) < 32 ? (T - t0) : 32;
        for (int qi = tid; qi < CL * 112; qi += NTHR) { const int i = qi / 112, c = (qi - i * 112) * 4;
            const int zc = (c < 192) ? (ZB_R + (c >> 6) * 512 + h * 64 + (c & 63)) : (ZB_XW + (c - 192));
            float cur[4] = {0.f, 0.f, 0.f, 0.f}, prv[4] = {0.f, 0.f, 0.f, 0.f};
            if (i < CL) { const v2u w = *(const v2u*)(F.Z() + (size_t)(row0 + t0 + i) * NZ + zc); cur[0] = bflo(w.x); cur[1] = bfhi(w.x); cur[2] = bflo(w.y); cur[3] = bfhi(w.y);
                if (i > 0) { const v2u p = *(const v2u*)(F.Z() + (size_t)(row0 + t0 + i - 1) * NZ + zc); prv[0] = bflo(p.x); prv[1] = bfhi(p.x); prv[2] = bflo(p.y); prv[3] = bfhi(p.y); }
                else { prv[0] = prevb[pb * 448 + c]; prv[1] = prevb[pb * 448 + c + 1]; prv[2] = prevb[pb * 448 + c + 2]; prv[3] = prevb[pb * 448 + c + 3]; }
                if (i == CL - 1) { prevb[(pb ^ 1) * 448 + c] = cur[0]; prevb[(pb ^ 1) * 448 + c + 1] = cur[1]; prevb[(pb ^ 1) * 448 + c + 2] = cur[2]; prevb[(pb ^ 1) * 448 + c + 3] = cur[3]; } }
            float zs[4];
#pragma unroll
            for (int j = 0; j < 4; ++j) zs[j] = cur[j] + (prv[j] - cur[j]) * mu[zc - ZB_R + j];
            if (c < 64) { LAS float* d = vec + (i * 7 + 4) * 64 + c; d[0] = zs[0]; d[1] = zs[1]; d[2] = zs[2]; d[3] = zs[3]; }
            else if (c < 128) { LAS float* d = kraw + i * 64 + (c - 64); d[0] = zs[0]; d[1] = zs[1]; d[2] = zs[2]; d[3] = zs[3]; }
            else if (c < 192) { LAS float* d = vec + (i * 7 + 5) * 64 + (c - 128); d[0] = zs[0]; d[1] = zs[1]; d[2] = zs[2]; d[3] = zs[3]; }
            else { const int cc = c - 192; float t4[4];
#pragma unroll
                for (int j = 0; j < 4; ++j) t4[j] = (cc < 64) ? ftanh(zs[j]) : ((cc < 128) ? zs[j] : fsigmoid(zs[j]));
                v2u w; w.x = pk2(t4[0], t4[1]); w.y = pk2(t4[2], t4[3]); *(LAS v2u*)(abuf + i * 264 + cc) = w; }
        }
        __syncthreads();
        {   f32x4 aw = {0.f, 0.f, 0.f, 0.f}, aa = aw, ag = aw;
            const LAS bf16* arow = abuf + (mt * 16 + fr) * 264 + 8 * fq;
#pragma unroll
            for (int ks = 0; ks < 2; ++ks) { const bf16x8 A1 = *(const LAS bf16x8*)(arow + 32 * ks), A2 = *(const LAS bf16x8*)(arow + 64 + 32 * ks);
                aw = __builtin_amdgcn_mfma_f32_16x16x32_bf16(A1, Bw[ks], aw, 0, 0, 0); aa = __builtin_amdgcn_mfma_f32_16x16x32_bf16(A2, Ba[ks], aa, 0, 0, 0); }
#pragma unroll
            for (int ks = 0; ks < 4; ++ks) { const bf16x8 A3 = *(const LAS bf16x8*)(arow + 128 + 32 * ks); ag = __builtin_amdgcn_mfma_f32_16x16x32_bf16(A3, Bg[ks], ag, 0, 0, 0); }
#pragma unroll
            for (int r = 0; r < 4; ++r) { const int tok = mt * 16 + 4 * fq + r, n = nt * 16 + fr; lor[(tok * 3 + 0) * 64 + n] = aw[r]; lor[(tok * 3 + 1) * 64 + n] = aa[r]; lor[(tok * 3 + 2) * 64 + n] = ag[r]; }
        }
        __syncthreads();
        {   const int i = tid >> 4, c0 = (tid & 15) * 4; float ss = 0.f, bs = 0.f; float kkv[4], av[4];
#pragma unroll
            for (int j = 0; j < 4; ++j) { const int c = c0 + j, hc = h * 64 + c;
                const float wl = lor[(i * 3 + 0) * 64 + c], al = lor[(i * 3 + 1) * 64 + c], gl = lor[(i * 3 + 2) * 64 + c];
                const float wlog = -fsoftplus(-(w0[hc] + wl)) - 0.5f; const float wdec = fexp(-fexp(wlog));
                const float a = fsigmoid(a0[hc] + al); const float kr = kraw[i * 64 + c]; const float kk = kr * k_k[hc];
                const float kp = kr * (1.f + (a - 1.f) * k_a[hc]);
                kkv[j] = kk; av[j] = a; ss += kk * kk; bs += vec[(i * 7 + 4) * 64 + c] * kp * r_k[hc];
                vec[(i * 7 + 1) * 64 + c] = wdec; vec[(i * 7 + 3) * 64 + c] = kp; vec[(i * 7 + 6) * 64 + c] = gl; }
            ss = sum16(ss); bs = sum16(bs); const float rn = __builtin_amdgcn_rsqf(ss + EPS);
#pragma unroll
            for (int j = 0; j < 4; ++j) { const int c = c0 + j; const float kn = kkv[j] * rn; vec[(i * 7 + 0) * 64 + c] = -kn; vec[(i * 7 + 2) * 64 + c] = kn * av[j]; }
            if ((tid & 15) == 0) bon[i] = bs;
        }
        __syncthreads();
        for (int t = 0; t < CL; ++t) {
            const LAS float* vp = vec + t * 7 * 64;
            const f32x4 n0 = *(const LAS f32x4*)(vp + 0 * 64 + sk0), n1 = *(const LAS f32x4*)(vp + 0 * 64 + sk0 + 4);
            const f32x4 w0v = *(const LAS f32x4*)(vp + 1 * 64 + sk0), w1v = *(const LAS f32x4*)(vp + 1 * 64 + sk0 + 4);
            const f32x4 a0v = *(const LAS f32x4*)(vp + 2 * 64 + sk0), a1v = *(const LAS f32x4*)(vp + 2 * 64 + sk0 + 4);
            const f32x4 k0v = *(const LAS f32x4*)(vp + 3 * 64 + sk0), k1v = *(const LAS f32x4*)(vp + 3 * 64 + sk0 + 4);
            const f32x4 r0v = *(const LAS f32x4*)(vp + 4 * 64 + sk0), r1v = *(const LAS f32x4*)(vp + 4 * 64 + sk0 + 4);
            const float vv = vp[5 * 64 + sv];
            float sa = (S[0] * n0[0] + S[1] * n0[1]) + (S[2] * n0[2] + S[3] * n0[3]) + (S[4] * n1[0] + S[5] * n1[1]) + (S[6] * n1[2] + S[7] * n1[3]);
            sa = sum8(sa);
            S[0] = S[0] * w0v[0] + sa * a0v[0] + vv * k0v[0]; S[1] = S[1] * w0v[1] + sa * a0v[1] + vv * k0v[1]; S[2] = S[2] * w0v[2] + sa * a0v[2] + vv * k0v[2]; S[3] = S[3] * w0v[3] + sa * a0v[3] + vv * k0v[3];
            S[4] = S[4] * w1v[0] + sa * a1v[0] + vv * k1v[0]; S[5] = S[5] * w1v[1] + sa * a1v[1] + vv * k1v[1]; S[6] = S[6] * w1v[2] + sa * a1v[2] + vv * k1v[2]; S[7] = S[7] * w1v[3] + sa * a1v[3] + vv * k1v[3];
            float oo = (S[0] * r0v[0] + S[1] * r0v[1]) + (S[2] * r0v[2] + S[3] * r0v[3]) + (S[4] * r1v[0] + S[5] * r1v[1]) + (S[6] * r1v[2] + S[7] * r1v[3]);
            oo = sum8(oo);
            if ((tid & 7) == 0) obuf[t * 64 + sv] = oo;
        }
        __syncthreads();
        {   const int i = tid >> 4, c0 = (tid & 15) * 4; float o4[4]; float s = 0.f;
#pragma unroll
            for (int j = 0; j < 4; ++j) { o4[j] = obuf[i * 64 + c0 + j]; s += o4[j]; }
            const float mean = sum16(s) * (1.f / 64.f); float q = 0.f;
#pragma unroll
            for (int j = 0; j < 4; ++j) { o4[j] -= mean; q += o4[j] * o4[j]; }
            const float rstd = __builtin_amdgcn_rsqf(sum16(q) * (1.f / 64.f) + B_LN_EPS); const float bo = bon[i];
            float y[4];
#pragma unroll
            for (int j = 0; j < 4; ++j) { const int c = c0 + j, hc = h * 64 + c; y[j] = (o4[j] * rstd * ln_w[hc] + ln_b[hc] + bo * vec[(i * 7 + 5) * 64 + c]) * vec[(i * 7 + 6) * 64 + c]; }
            if (i < CL) { v2u w; w.x = pk2(y[0], y[1]); w.y = pk2(y[2], y[3]); *(v2u*)(F.Z() + (size_t)(row0 + t0 + i) * NZ + ZB_R + h * 64 + c0) = w; }
        }
        __syncthreads();
        pb ^= 1;
    }
    if (F.omask & OM_B_S) {
#pragma unroll
        for (int j = 0; j < 8; ++j) Sout[(size_t)sv * 64 + sk0 + j] = S[j]; }
}

typedef short bf16x4s __attribute__((ext_vector_type(4)));
__device__ __forceinline__ f32x4 mfma16(bf16x4s a, bf16x4s b, f32x4 c) { return __builtin_amdgcn_mfma_f32_16x16x16bf16_1k(a, b, c, 0, 0, 0); }
__device__ __forceinline__ bf16x4s cvt4(const f32x4 a) { const v2u w = {pg8::cvt_pk_bf16(a[0], a[1]), pg8::cvt_pk_bf16(a[2], a[3])}; return __builtin_bit_cast(bf16x4s, w); }
__device__ __forceinline__ bf16x8 frag_perm(const LAS bf16* rowp) {
    const bf16x4 lo = *(const LAS bf16x4*)rowp, hi = *(const LAS bf16x4*)(rowp + 16);
    return (bf16x8){lo[0], lo[1], lo[2], lo[3], hi[0], hi[1], hi[2], hi[3]};
}
constexpr int AP_Q = 0, AP_K = 17408, AP_V = 34816, AP_L = 52224, AP_AT = 68608, AP_GC = 77824, AP_LB = 78848, AP_T = 88064, AP_CW = 90112;
__device__ __forceinline__ void gdn_prep_weights(Frame& F, int l, int h) {
    const int tid = opaque_tid(F); const float* conv_w = F.in[10] + (size_t)l * 4 * 1536; LAS float* cw = (LAS float*)(F.lds + AP_CW);
    for (int i = tid; i < 4 * 384; i += NTHR) { const int tap = i / 384, r = i - tap * 384; cw[i] = conv_w[tap * 1536 + (r >> 7) * 512 + h * 128 + (r & 127)]; }
    __syncthreads();
}
__device__ __forceinline__ void gdn_prep_unit(Frame& F, int l, int b, int c, int h) {
    const int tid = opaque_tid(F), lane = tid & 63, wv = __builtin_amdgcn_readfirstlane(tid >> 6);
    LAS bf16* qs = (LAS bf16*)(F.lds + AP_Q); LAS bf16* ks = (LAS bf16*)(F.lds + AP_K); LAS bf16* vs = (LAS bf16*)(F.lds + AP_V);
    LAS float* Lm = (LAS float*)(F.lds + AP_L); LAS bf16* at = (LAS bf16*)(F.lds + AP_AT); LAS float* gcs = (LAS float*)(F.lds + AP_GC);
    LAS bf16* Lb = (LAS bf16*)(F.lds + AP_LB); LAS bf16* Tb = (LAS bf16*)(F.lds + AP_T); const LAS float* cw = (const LAS float*)(F.lds + AP_CW);
    const size_t t0 = (size_t)b * SEQ + 64 * c; const int unit = (b * 32 + c) * 4 + h;
    {   const int tok = tid >> 3, cg = tid & 7;
        v4u xin[3][4][2];
#pragma unroll
        for (int tap = 0; tap < 4; ++tap) { const int j = tok + tap - 3; const bool ok = (j >= 0) || (c > 0);
            const bf16* rowp = (j >= 0) ? F.Z() + (t0 + j) * NZ + h * 128 + cg * 16 : F.HALO_A() + ((size_t)(b * 33 + c) * 3 + (3 + j)) * 1536 + h * 128 + cg * 16;
#pragma unroll
            for (int seg = 0; seg < 3; ++seg) { v4u x0 = {0u, 0u, 0u, 0u}, x1 = x0;
                if (ok) { const v4u* p = (const v4u*)(rowp + seg * 512); x0 = p[0]; x1 = p[1]; }
                xin[seg][tap][0] = x0; xin[seg][tap][1] = x1; } }
#pragma unroll
        for (int seg = 0; seg < 3; ++seg) { float acc[16];
#pragma unroll
            for (int e = 0; e < 16; ++e) acc[e] = 0.f;
#pragma unroll
            for (int tap = 0; tap < 4; ++tap) { const v4u x0 = xin[seg][tap][0], x1 = xin[seg][tap][1];
                const LAS f32x4* wp = (const LAS f32x4*)(cw + tap * 384 + seg * 128 + cg * 16); const f32x4 wa = wp[0], wb = wp[1], wc = wp[2], wd = wp[3];
                acc[0] += bflo(x0.x) * wa[0]; acc[1] += bfhi(x0.x) * wa[1]; acc[2] += bflo(x0.y) * wa[2]; acc[3] += bfhi(x0.y) * wa[3];
                acc[4] += bflo(x0.z) * wb[0]; acc[5] += bfhi(x0.z) * wb[1]; acc[6] += bflo(x0.w) * wb[2]; acc[7] += bfhi(x0.w) * wb[3];
                acc[8] += bflo(x1.x) * wc[0]; acc[9] += bfhi(x1.x) * wc[1]; acc[10] += bflo(x1.y) * wc[2]; acc[11] += bfhi(x1.y) * wc[3];
                acc[12] += bflo(x1.z) * wd[0]; acc[13] += bfhi(x1.z) * wd[1]; acc[14] += bflo(x1.w) * wd[2]; acc[15] += bfhi(x1.w) * wd[3]; }
            float ss = 0.f;
#pragma unroll
            for (int e = 0; e < 16; ++e) { acc[e] = fsilu(acc[e]); ss += acc[e] * acc[e]; }
            float sc = 1.f;
            if (seg < 2) { ss = sum8(ss); sc = __builtin_amdgcn_rsqf(ss + EPS); if (seg == 0) sc *= 0.08838834764831845f; }
            v4u o0, o1; o0.x = pk2(acc[0] * sc, acc[1] * sc); o0.y = pk2(acc[2] * sc, acc[3] * sc); o0.z = pk2(acc[4] * sc, acc[5] * sc); o0.w = pk2(acc[6] * sc, acc[7] * sc);
            o1.x = pk2(acc[8] * sc, acc[9] * sc); o1.y = pk2(acc[10] * sc, acc[11] * sc); o1.z = pk2(acc[12] * sc, acc[13] * sc); o1.w = pk2(acc[14] * sc, acc[15] * sc);
            LAS bf16* dst = (seg == 0 ? qs : (seg == 1 ? ks : vs)) + tok * 136 + cg * 16; *(LAS v4u*)dst = o0; *(LAS v4u*)(dst + 8) = o1; }
    }
    if (wv == 0) { const float g0 = F.BG()[(t0 + lane) * 8 + 4 + h]; const float be = F.BG()[(t0 + lane) * 8 + h];
        gcs[192 + lane] = g0; LDS_WAIT();
        float g = 0.f, glast = 0.f;
#pragma unroll 8
        for (int j = 0; j < 64; ++j) { const float v = gcs[192 + j]; glast += v; g += (j <= lane) ? v : 0.f; }
        LDS_WAIT();
        gcs[lane] = g; gcs[64 + lane] = be; gcs[128 + lane] = fexp(g); gcs[192 + lane] = fexp(glast - g);
        if (lane == 63) F.GL()[unit] = fexp(g); }
    __syncthreads();
    {   const int p = wv >> 2, mt = wv & 3, fq = lane >> 4, fr = lane & 15;
        const LAS bf16* Ar = (p == 0 ? ks : qs) + (mt * 16 + fr) * 136 + 8 * fq;
#pragma unroll
        for (int nt = 0; nt < 4; ++nt) { f32x4 acc = {0.f, 0.f, 0.f, 0.f};
            if (nt <= mt) { const LAS bf16* Br = ks + (nt * 16 + fr) * 136 + 8 * fq;
#pragma unroll
                for (int kst = 0; kst < 4; ++kst) acc = __builtin_amdgcn_mfma_f32_16x16x32_bf16(*(const LAS bf16x8*)(Ar + 32 * kst), *(const LAS bf16x8*)(Br + 32 * kst), acc, 0, 0, 0); }
            if (p == 1 || nt <= mt) {
#pragma unroll
                for (int r = 0; r < 4; ++r) { const int i = mt * 16 + 4 * fq + r, j = nt * 16 + fr; const float dec = fexp(fminf(gcs[i] - gcs[j], 0.f));
                    if (p == 0) { const float lv = (i > j) ? gcs[64 + i] * acc[r] * dec : 0.f; if (nt == mt) Lm[i * 64 + j] = lv; else Lb[i * 72 + j] = (bf16)f2bf(-lv); }
                    else at[i * 72 + j] = (bf16)f2bf((i >= j) ? acc[r] * dec : 0.f); } } }
    }
    __syncthreads();
    if (wv == 0) { const int blk = lane >> 4, e = lane & 15; float t[16];
#pragma unroll
        for (int r = 0; r < 16; ++r) { float s = (r == e) ? 1.f : 0.f; const LAS float* Lr = Lm + (16 * blk + r) * 64 + 16 * blk;
#pragma unroll
            for (int m4 = 0; m4 < (r + 3) / 4; ++m4) { const f32x4 lv = *(const LAS f32x4*)(Lr + 4 * m4);
#pragma unroll
                for (int e2 = 0; e2 < 4; ++e2) if (4 * m4 + e2 < r) s -= lv[e2] * t[4 * m4 + e2]; }
            t[r] = s; }
#pragma unroll
        for (int r = 0; r < 16; ++r) Tb[blk * 256 + r * 16 + e] = (bf16)f2bf(t[r]);
    } else {
        const int t2 = tid - 64;
        for (int ch = t2; ch < 1024; ch += 448) { const int i = ch >> 4, d0 = (ch & 15) * 8; const v4u q = *(const LAS v4u*)(qs + i * 136 + d0); const float e = gcs[128 + i];
            v4u o; o.x = pk2(bflo(q.x) * e, bfhi(q.x) * e); o.y = pk2(bflo(q.y) * e, bfhi(q.y) * e); o.z = pk2(bflo(q.z) * e, bfhi(q.z) * e); o.w = pk2(bflo(q.w) * e, bfhi(q.w) * e);
            *(v4u*)(F.Z() + (t0 + i) * NZ + ZA_Q + h * 128 + d0) = o; }
        for (int ch = t2; ch < 1024; ch += 448) { const int kd = ch >> 3, tg = ch & 7; float v[8];
#pragma unroll
            for (int j = 0; j < 8; ++j) v[j] = bf2f(ks[(8 * tg + j) * 136 + kd]) * gcs[192 + 8 * tg + j];
            v4u o; o.x = pk2(v[0], v[1]); o.y = pk2(v[2], v[3]); o.z = pk2(v[4], v[5]); o.w = pk2(v[6], v[7]);
            *(v4u*)(F.Z() + (t0 + (kd >> 1)) * NZ + ZA_K + h * 128 + (kd & 1) * 64 + 8 * tg) = o; }
        for (int ch = t2; ch < 512; ch += 448) { const int i = ch >> 3, j0 = (ch & 7) * 8; *(v4u*)(F.GATT() + (size_t)unit * 4096 + i * 64 + j0) = *(const LAS v4u*)(at + i * 72 + j0); }
    }
    __syncthreads();
    {   int ln = lane; asm volatile("" : "+v"(ln)); const int fq = ln >> 4, fr = ln & 15;
        LAS bf16* src = ((wv < 4) ? vs : ks) + 32 * (wv & 3) + fr; const bool isk = wv >= 4;
        float rsc[4][4];
#pragma unroll
        for (int i = 0; i < 4; ++i)
#pragma unroll
            for (int r = 0; r < 4; ++r) { const int row = 16 * i + 4 * fq + r; const float eg = gcs[128 + row]; rsc[i][r] = gcs[64 + row] * (isk ? eg : 1.0f); }
        bf16x4s Tf[4];
#pragma unroll
        for (int i = 0; i < 4; ++i) Tf[i] = *(const LAS bf16x4s*)(Tb + i * 256 + fr * 16 + 4 * fq);
        const bf16x4s L10 = *(const LAS bf16x4s*)(Lb + (16 + fr) * 72 + 4 * fq), L32 = *(const LAS bf16x4s*)(Lb + (48 + fr) * 72 + 32 + 4 * fq);
        const bf16x8 L2 = frag_perm(Lb + (32 + fr) * 72 + 4 * fq), L3 = frag_perm(Lb + (48 + fr) * 72 + 4 * fq);
        const f32x4 z4 = {0.f, 0.f, 0.f, 0.f};
#pragma unroll
        for (int g = 0; g < 2; ++g) { f32x4 R[4];
#pragma unroll
            for (int i = 0; i < 4; ++i)
#pragma unroll
                for (int r = 0; r < 4; ++r) R[i][r] = bf2f(src[(16 * i + 4 * fq + r) * 136 + 16 * g]) * rsc[i][r];
            const bf16x4s X0 = cvt4(mfma16(Tf[0], cvt4(R[0]), z4));
            const bf16x4s X1 = cvt4(mfma16(Tf[1], cvt4(mfma16(L10, X0, R[1])), z4));
            const bf16x8 X01 = {X0[0], X0[1], X0[2], X0[3], X1[0], X1[1], X1[2], X1[3]};
            const bf16x4s X2 = cvt4(mfma16(Tf[2], cvt4(__builtin_amdgcn_mfma_f32_16x16x32_bf16(L2, X01, R[2], 0, 0, 0)), z4));
            const bf16x4s X3 = cvt4(mfma16(Tf[3], cvt4(mfma16(L32, X2, __builtin_amdgcn_mfma_f32_16x16x32_bf16(L3, X01, R[3], 0, 0, 0))), z4));
            const int col = 32 * (wv & 3) + 16 * g + fr;
            bf16* dstp = isk ? F.GW() + (size_t)unit * 8192 + col : F.Z() + t0 * NZ + ZA_V + h * 128 + col; const size_t ldo = isk ? 128 : NZ;
#pragma unroll
            for (int r = 0; r < 4; ++r) { dstp[(size_t)(4 * fq + r) * ldo] = (bf16)X0[r]; dstp[(size_t)(16 + 4 * fq + r) * ldo] = (bf16)X1[r];
                dstp[(size_t)(32 + 4 * fq + r) * ldo] = (bf16)X2[r]; dstp[(size_t)(48 + 4 * fq + r) * ldo] = (bf16)X3[r]; } }
    }
    __syncthreads();
}

constexpr int AS_W = 0, AS_QG = 17408, AS_U = 34816, AS_KT = 52224, AS_AT = 70656, AS_G = 79872, AS_PS = 97280, AS_RS = 99328;
__device__ __forceinline__ bf16x8 pack_acc(const f32x4 a, const f32x4 b) {
    const unsigned w0 = pg8::cvt_pk_bf16(a[0], a[1]), w1 = pg8::cvt_pk_bf16(a[2], a[3]), w2 = pg8::cvt_pk_bf16(b[0], b[1]), w3 = pg8::cvt_pk_bf16(b[2], b[3]);
    const v4u w = {w0, w1, w2, w3}; return __builtin_bit_cast(bf16x8, w);
}
__device__ __forceinline__ void gdn_scan_unit(Frame& F, int l, int b, int h) {
    const int tid = opaque_tid(F), lane = tid & 63, e = __builtin_amdgcn_readfirstlane(tid >> 6), fq = lane >> 4, fr = lane & 15, dv = 16 * e + fr;
    LAS bf16* wS = (LAS bf16*)(F.lds + AS_W); LAS bf16* qgS = (LAS bf16*)(F.lds + AS_QG); LAS bf16* uS = (LAS bf16*)(F.lds + AS_U);
    LAS bf16* ktS = (LAS bf16*)(F.lds + AS_KT); LAS bf16* atS = (LAS bf16*)(F.lds + AS_AT); LAS bf16* gS = (LAS bf16*)(F.lds + AS_G);
    LAS float* ps = (LAS float*)(F.lds + AS_PS); LAS float* rsv = (LAS float*)(F.lds + AS_RS);
    const float ng = (F.in[13] + l * 128)[dv];
    f32x4 S[8];
#pragma unroll
    for (int t = 0; t < 8; ++t) S[t] = (f32x4){0.f, 0.f, 0.f, 0.f};
    v4u pw[2], pq[2], pu[2], pk[2], pg[2], pa; float pgl;
    const int i0 = tid >> 4, d0 = (tid & 15) * 8;
#define AS_FETCH(c) do { const size_t _t0 = (size_t)b * SEQ + 64 * (c); const int _un = (b * 32 + (c)) * 4 + h; \
        _Pragma("unroll") for (int _j = 0; _j < 2; ++_j) { const int _i = i0 + 32 * _j; const bf16* _zr = F.Z() + (_t0 + _i) * NZ + h * 128 + d0; \
            pw[_j] = *(const v4u*)(F.GW() + (size_t)_un * 8192 + _i * 128 + d0); pq[_j] = *(const v4u*)(_zr + ZA_Q); pu[_j] = *(const v4u*)(_zr + ZA_V); pk[_j] = *(const v4u*)(_zr + ZA_K); pg[_j] = *(const v4u*)(_zr + ZA_G); } \
        pa = *(const v4u*)(F.GATT() + (size_t)_un * 4096 + (tid >> 3) * 64 + (tid & 7) * 8); pgl = F.GL()[_un]; } while (0)
    AS_FETCH(0);
    float yprev[4][4];
    for (int c = 0; c < 32; ++c) {
        const size_t t0 = (size_t)b * SEQ + 64 * c;
#pragma unroll
        for (int j = 0; j < 2; ++j) { const int i = i0 + 32 * j;
            *(LAS v4u*)(wS + i * 136 + d0) = pw[j]; *(LAS v4u*)(qgS + i * 136 + d0) = pq[j]; *(LAS v4u*)(uS + i * 136 + d0) = pu[j]; *(LAS v4u*)(gS + i * 136 + d0) = pg[j];
            { const int part = tid & 15; *(LAS v4u*)(ktS + (2 * i + (part >> 3)) * 72 + (part & 7) * 8) = pk[j]; } }
        *(LAS v4u*)(atS + (tid >> 3) * 72 + (tid & 7) * 8) = pa;
        const float glast = pgl;
        __syncthreads();
        if (c > 0) {
#pragma unroll
            for (int mt = 0; mt < 4; ++mt)
#pragma unroll
                for (int r = 0; r < 4; ++r) F.Z()[(t0 - 64 + 16 * mt + 4 * fq + r) * NZ + ZA_G + h * 128 + dv] = (bf16)f2bf(yprev[mt][r]); }
        if (c + 1 < 32) AS_FETCH(c + 1);
        bf16x8 Sb[4];
#pragma unroll
        for (int kt = 0; kt < 4; ++kt) Sb[kt] = pack_acc(S[2 * kt], S[2 * kt + 1]);
        f32x4 vn[4], oo[4];
#pragma unroll
        for (int mt = 0; mt < 4; ++mt) { f32x4 pw_ = {0.f, 0.f, 0.f, 0.f}, po = pw_;
            bf16x8 fw[4], fqg[4];
#pragma unroll
            for (int kt = 0; kt < 4; ++kt) { fw[kt] = frag_perm(wS + (16 * mt + fr) * 136 + 32 * kt + 4 * fq); fqg[kt] = frag_perm(qgS + (16 * mt + fr) * 136 + 32 * kt + 4 * fq); }
            float u4[4];
#pragma unroll
            for (int r = 0; r < 4; ++r) u4[r] = bf2f(uS[(16 * mt + 4 * fq + r) * 136 + dv]);
#pragma unroll
            for (int kt = 0; kt < 4; ++kt) { pw_ = __builtin_amdgcn_mfma_f32_16x16x32_bf16(fw[kt], Sb[kt], pw_, 0, 0, 0); po = __builtin_amdgcn_mfma_f32_16x16x32_bf16(fqg[kt], Sb[kt], po, 0, 0, 0); }
#pragma unroll
            for (int r = 0; r < 4; ++r) vn[mt][r] = u4[r] - pw_[r];
            oo[mt] = po; }
        bf16x8 Vb[2];
        Vb[0] = pack_acc(vn[0], vn[1]); Vb[1] = pack_acc(vn[2], vn[3]);
        {   bf16x8 fat[4][2];
#pragma unroll
            for (int mt = 0; mt < 4; ++mt)
#pragma unroll
                for (int k2 = 0; k2 < 2; ++k2) fat[mt][k2] = frag_perm(atS + (16 * mt + fr) * 72 + 32 * k2 + 4 * fq);
#pragma unroll
            for (int mt = 0; mt < 4; ++mt)
#pragma unroll
                for (int k2 = 0; k2 < 2; ++k2) oo[mt] = __builtin_amdgcn_mfma_f32_16x16x32_bf16(fat[mt][k2], Vb[k2], oo[mt], 0, 0, 0); }
#pragma unroll
        for (int th = 0; th < 2; ++th) { bf16x8 fkt[4][2];
#pragma unroll
            for (int t = 0; t < 4; ++t)
#pragma unroll
                for (int k2 = 0; k2 < 2; ++k2) fkt[t][k2] = frag_perm(ktS + (16 * (4 * th + t) + fr) * 72 + 32 * k2 + 4 * fq);
#pragma unroll
            for (int t = 0; t < 4; ++t) { f32x4 a = S[4 * th + t] * glast;
#pragma unroll
                for (int k2 = 0; k2 < 2; ++k2) a = __builtin_amdgcn_mfma_f32_16x16x32_bf16(fkt[t][k2], Vb[k2], a, 0, 0, 0);
                S[4 * th + t] = a; } }
        float gate[4][4];
#pragma unroll
        for (int mt = 0; mt < 4; ++mt)
#pragma unroll
            for (int r = 0; r < 4; ++r) { gate[mt][r] = bf2f(gS[(16 * mt + 4 * fq + r) * 136 + dv]); const float q = sum16(oo[mt][r] * oo[mt][r]); if (fr == 0) ps[e * 64 + 16 * mt + 4 * fq + r] = q; }
        __syncthreads();
        if (tid < 64) { float s = 0.f;
#pragma unroll
            for (int w = 0; w < 8; ++w) s += ps[w * 64 + tid];
            rsv[tid] = __builtin_amdgcn_rsqf(s * (1.f / 128.f) + EPS); }
        __syncthreads();
#pragma unroll
        for (int mt = 0; mt < 4; ++mt)
#pragma unroll
            for (int r = 0; r < 4; ++r) { const int tok = 16 * mt + 4 * fq + r; yprev[mt][r] = oo[mt][r] * rsv[tok] * ng * fsilu(gate[mt][r]); }
        __syncthreads();
    }
    {   const size_t t0 = (size_t)b * SEQ + 64 * 32;
#pragma unroll
        for (int mt = 0; mt < 4; ++mt)
#pragma unroll
            for (int r = 0; r < 4; ++r) F.Z()[(t0 - 64 + 16 * mt + 4 * fq + r) * NZ + ZA_G + h * 128 + dv] = (bf16)f2bf(yprev[mt][r]); }
#undef AS_FETCH
    if (F.omask & OM_A_S) { float* o = F.p_a_S() + ((size_t)(l * NB + b) * 4 + h) * 128 * 128;
#pragma unroll
        for (int t = 0; t < 8; ++t)
#pragma unroll
            for (int r = 0; r < 4; ++r) o[(size_t)(16 * t + 4 * fq + r) * 128 + dv] = S[t][r]; }
}

constexpr int GS_QKV = 0, GS_PART = 2048, GS_PART2 = 4096, GS_RED = 6144;
__device__ __forceinline__ void gdn_sample_unit(Frame& F, int l, int sb, int h) {
    const int tid = opaque_tid(F), lane = tid & 63, wv = __builtin_amdgcn_readfirstlane(tid >> 6), dv = tid & 127, kg = tid >> 7;
    LAS float* qkv = (LAS float*)(F.lds + GS_QKV); LAS float* part = (LAS float*)(F.lds + GS_PART); LAS float* part2 = (LAS float*)(F.lds + GS_PART2); LAS float* red = (LAS float*)(F.lds + GS_RED);
    const float* conv_w = F.in[10] + (size_t)l * 4 * 1536; const float* cst = F.in[3] + ((size_t)l * NSB + sb) * 3 * 1536;
    const float* S0 = F.in[2] + (((size_t)l * NSB + sb) * 4 + h) * 128 * 128; const float ng = (F.in[13] + l * 128)[dv];
    float S[32];
#pragma unroll
    for (int j = 0; j < 32; ++j) S[j] = S0[(size_t)(32 * kg + j) * 128 + dv];
    for (int t = 0; t < TS; ++t) {
        const size_t row = (size_t)MP + sb * TS + t;
        if (tid < 384) { const int seg = tid >> 7, col = seg * 512 + h * 128 + dv; float y = 0.f;
#pragma unroll
            for (int tap = 0; tap < 4; ++tap) { const int j = t + tap - 3; const float x = (j >= 0) ? bf2f(F.Z()[((size_t)MP + sb * TS + j) * NZ + col]) : cst[(size_t)(j + 3) * 1536 + col]; y += x * conv_w[tap * 1536 + col]; }
            y = fsilu(y); qkv[seg * 128 + dv] = y;
            if (seg < 2) { const float ss = wave_sum(y * y); if (lane == 0) red[wv] = ss; } }
        __syncthreads();
        const float rnq = __builtin_amdgcn_rsqf(red[0] + red[1] + EPS) * 0.08838834764831845f, rnk = __builtin_amdgcn_rsqf(red[2] + red[3] + EPS);
        const float beta = F.BG()[row * 8 + h], eg = fexp(F.BG()[row * 8 + 4 + h]);
        float pd = 0.f;
#pragma unroll
        for (int j = 0; j < 32; ++j) { S[j] *= eg; pd += S[j] * qkv[128 + 32 * kg + j]; }
        part[kg * 128 + dv] = pd * rnk;
        __syncthreads();
        const float tot = (part[dv] + part[128 + dv]) + (part[256 + dv] + part[384 + dv]);
        const float dd = beta * (qkv[256 + dv] - tot) * rnk; float po = 0.f;
#pragma unroll
        for (int j = 0; j < 32; ++j) { S[j] += qkv[128 + 32 * kg + j] * dd; po += S[j] * qkv[32 * kg + j]; }
        part2[kg * 128 + dv] = po * rnq;
        __syncthreads();
        float o = 0.f;
        if (kg == 0) { o = (part2[dv] + part2[128 + dv]) + (part2[256 + dv] + part2[384 + dv]); const float ss = wave_sum(o * o); if (lane == 0) red[4 + wv] = ss; }
        __syncthreads();
        if (kg == 0) { const float rs = __builtin_amdgcn_rsqf((red[4] + red[5]) * (1.f / 128.f) + EPS); bf16* gp = F.Z() + row * NZ + ZA_G + h * 128 + dv;
            *gp = (bf16)f2bf(o * rs * ng * fsilu(bf2f(*gp))); }
        __syncthreads();
    }
    if (F.omask & OM_A_S) { float* o = F.s_a_S() + (((size_t)l * NSB + sb) * 4 + h) * 128 * 128;
#pragma unroll
        for (int j = 0; j < 32; ++j) o[(size_t)(32 * kg + j) * 128 + dv] = S[j]; }
}

constexpr int CP_XA = 0, CP_RI = 66560;
template <bool SAMPLE>
__device__ __forceinline__ void rglru_prep_unit(Frame& F, int l, int b, int c) {
    const int tid = opaque_tid(F), lane = tid & 63, g = __builtin_amdgcn_readfirstlane(tid >> 6), fq = lane >> 4, fr = lane & 15, ch = tid;
    LAS bf16* xa = (LAS bf16*)(F.lds + CP_XA); LAS float* ri = (LAS float*)(F.lds + CP_RI);
    const float* cw = F.in[25] + (size_t)l * 4 * 512; const float cb = (F.in[26] + l * 512)[ch];
    const float* ba = F.in[28] + l * 512; const float* bx = F.in[30] + l * 512; const float cL = (F.in[31] + l * 512)[ch];
    const size_t t0 = SAMPLE ? (size_t)MP + 64 * b : (size_t)b * SEQ + 64 * c;
    const float w0 = cw[ch], w1 = cw[512 + ch], w2 = cw[1024 + ch], w3 = cw[1536 + ch];
    {   float xm3 = 0.f, xm2 = 0.f, xm1 = 0.f;
        if (!SAMPLE && c > 0) { const bf16* hp = F.HALO_C() + (size_t)(b * 33 + c) * 3 * 512 + ch; xm3 = bf2f(hp[0]); xm2 = bf2f(hp[512]); xm1 = bf2f(hp[1024]); }
#pragma unroll 1
        for (int tb = 0; tb < 64; tb += 16) { float xr[16];
#pragma unroll
            for (int t = 0; t < 16; ++t) xr[t] = bf2f(F.Z()[(t0 + tb + t) * NZ + ZC_X + ch]);
#pragma unroll
            for (int t = 0; t < 16; ++t) {
                if (SAMPLE && (t & 3) == 0) { const float* sp = F.in[7] + ((size_t)l * NSB + 16 * b + ((tb + t) >> 2)) * 3 * 512 + ch; xm3 = sp[0]; xm2 = sp[512]; xm1 = sp[1024]; }
                const float x = xr[t];
                const float v = w0 * xm3 + w1 * xm2 + w2 * xm1 + w3 * x + cb; xm3 = xm2; xm2 = xm1; xm1 = x;
                xa[(tb + t) * 520 + ch] = (bf16)f2bf(v); } } }
    bf16x8 Ba[4][2], Bx[4][2];
#pragma unroll
    for (int nt = 0; nt < 4; ++nt)
#pragma unroll
        for (int ks = 0; ks < 2; ++ks) { Ba[nt][ks] = *(const bf16x8*)(F.WCA() + (size_t)g * 4096 + (16 * nt + fr) * 64 + 32 * ks + 8 * fq); Bx[nt][ks] = *(const bf16x8*)(F.WCX() + (size_t)g * 4096 + (16 * nt + fr) * 64 + 32 * ks + 8 * fq); }
    const float sp = fsoftplus(-cL);
    float P = 1.f, hl = 0.f;
    __syncthreads();
#pragma unroll
    for (int mt = 0; mt < 4; ++mt) {
        {   f32x4 ar[4], ai[4];
#pragma unroll
            for (int nt = 0; nt < 4; ++nt) { ar[nt] = (f32x4){0.f, 0.f, 0.f, 0.f}; ai[nt] = ar[nt]; }
#pragma unroll
            for (int ks = 0; ks < 2; ++ks) { const bf16x8 A = *(const LAS bf16x8*)(xa + (16 * mt + fr) * 520 + g * 64 + 32 * ks + 8 * fq);
#pragma unroll
                for (int nt = 0; nt < 4; ++nt) { ar[nt] = __builtin_amdgcn_mfma_f32_16x16x32_bf16(A, Ba[nt][ks], ar[nt], 0, 0, 0); ai[nt] = __builtin_amdgcn_mfma_f32_16x16x32_bf16(A, Bx[nt][ks], ai[nt], 0, 0, 0); } }
#pragma unroll
            for (int nt = 0; nt < 4; ++nt) { const int co = g * 64 + 16 * nt + fr; const float bav = ba[co], bxv = bx[co];
#pragma unroll
                for (int r = 0; r < 4; ++r) { const int tl = 4 * fq + r; *(LAS f32x2*)(ri + (tl * 512 + co) * 2) = (f32x2){fsigmoid(ar[nt][r] + bav), fsigmoid(ai[nt][r] + bxv)}; } }
        }
        __syncthreads();
        float gbv[16];
#pragma unroll
        for (int tl = 0; tl < 16; ++tl) gbv[tl] = bf2f(F.Z()[(t0 + 16 * mt + tl) * NZ + ZC_G + ch]);
#pragma unroll
        for (int tl = 0; tl < 16; ++tl) { const int t = 16 * mt + tl; const f32x2 rv = *(const LAS f32x2*)(ri + (tl * 512 + ch) * 2);
            const float log_a = -8.f * rv[0] * sp; const float a = fexp(log_a); const float bb = sqrtf(fmaxf(-expm1f(2.f * log_a), 0.f)) * (rv[1] * bf2f(xa[t * 520 + ch]));
            bf16* gp = F.Z() + (t0 + t) * NZ + ZC_G + ch; const float ge = fgelu(gbv[tl]);
            if (SAMPLE) {
                if ((t & 3) == 0) hl = (F.in[6] + ((size_t)l * NSB + 16 * b + (t >> 2)) * 512)[ch];
                hl = a * hl + bb; *gp = (bf16)f2bf(hl * ge);
                if ((t & 3) == 3 && (F.omask & OM_C_H)) (F.s_c_h() + ((size_t)l * NSB + 16 * b + (t >> 2)) * 512)[ch] = hl;
            } else { P *= a; hl = a * hl + bb; F.Z()[(t0 + t) * NZ + ZC_X + ch] = (bf16)f2bf(P * ge); *gp = (bf16)f2bf(hl * ge); } }
        __syncthreads();
    }
    if (!SAMPLE) { float* cs = F.CSUM() + ((size_t)(b * 32 + c) * 512 + ch) * 2; cs[0] = P; cs[1] = hl; }
}
__device__ __forceinline__ void rglru_fix_unit(Frame& F, int l, int b, int c) {
    const int ch = opaque_tid(F); float carry = 0.f;
    {   f32x2 cs[31];
#pragma unroll
        for (int j = 0; j < 31; ++j) cs[j] = (j < c) ? *(const f32x2*)(F.CSUM() + ((size_t)(b * 32 + j) * 512 + ch) * 2) : (f32x2){1.f, 0.f};
#pragma unroll
        for (int j = 0; j < 31; ++j) carry = cs[j][0] * carry + cs[j][1]; }
    const size_t t0 = (size_t)b * SEQ + 64 * c;
#pragma unroll 1
    for (int tb = 0; tb < 64; tb += 16) { float a1[16], a2[16];
#pragma unroll
        for (int t = 0; t < 16; ++t) { const bf16* p = F.Z() + (t0 + tb + t) * NZ; a1[t] = bf2f(p[ZC_X + ch]); a2[t] = bf2f(p[ZC_G + ch]); }
#pragma unroll
        for (int t = 0; t < 16; ++t) F.Z()[(t0 + tb + t) * NZ + ZC_G + ch] = (bf16)f2bf(a1[t] * carry + a2[t]); }
    if (c == 31 && (F.omask & OM_C_H)) { const float* cs = F.CSUM() + ((size_t)(b * 32 + 31) * 512 + ch) * 2; (F.p_c_h() + (size_t)(l * NB + b) * 512)[ch] = cs[0] * carry + cs[1]; }
}
constexpr int RC_ABUF = 0, RC_RF = 16896, RC_KRAW = 25088, RC_VF = 33280, RC_LOR = 41472, RC_LW = 66048, RC_PV = 74240, RC_PG = 82432, RC_PR = 90624, RC_PK = 98816,
              RC_AH = 107008, RC_BH = 111616, RC_KH = 116224, RC_RH = 120832, RC_AHT = 125440, RC_BTT = 129536, RC_KTT = 133632, RC_VT = 137728, RC_GC = 141824, RC_RN = 142336, RC_OB = 142464, RC_PREV = 150656, RC_MU = 154240;
__device__ __forceinline__ f32x4 add_eye(f32x4 x, int fq, int fr) {
#pragma unroll
    for (int r = 0; r < 4; ++r) x[r] += (4 * fq + r == fr) ? 1.f : 0.f;
    return x; }
__device__ __forceinline__ void rwkv_chain_chunked(Frame& F, int l, int b, int h) {
    const int tid = opaque_tid(F), lane0 = tid & 63, wv = __builtin_amdgcn_readfirstlane(tid >> 6);
#define RC_LANE() int lane = lane0; asm volatile("" : "+v"(lane)); const int fq = lane >> 4, fr = lane & 15; (void)fq; (void)fr
    const int hc = h * 64 + lane0;
    LAS unsigned char* L = F.lds;
    LAS bf16* abuf = (LAS bf16*)(L + RC_ABUF); LAS float* rf = (LAS float*)(L + RC_RF); LAS float* kraw = (LAS float*)(L + RC_KRAW); LAS float* vf = (LAS float*)(L + RC_VF);
    LAS float* lor = (LAS float*)(L + RC_LOR); LAS float* LW = (LAS float*)(L + RC_LW); LAS float* PV = (LAS float*)(L + RC_PV); LAS float* PG = (LAS float*)(L + RC_PG);
    LAS float* PR = (LAS float*)(L + RC_PR); LAS float* PK = (LAS float*)(L + RC_PK); LAS float* RN = (LAS float*)(L + RC_RN);
    LAS bf16* AH = (LAS bf16*)(L + RC_AH); LAS bf16* BH = (LAS bf16*)(L + RC_BH); LAS bf16* KH = (LAS bf16*)(L + RC_KH); LAS bf16* RH = (LAS bf16*)(L + RC_RH);
    LAS bf16* AHT = (LAS bf16*)(L + RC_AHT); LAS bf16* BTT = (LAS bf16*)(L + RC_BTT); LAS bf16* KTT = (LAS bf16*)(L + RC_KTT); LAS bf16* VT = (LAS bf16*)(L + RC_VT); LAS float* GC = (LAS float*)(L + RC_GC);
    LAS float* OB = (LAS float*)(L + RC_OB); LAS float* prevb = (LAS float*)(L + RC_PREV); LAS float* muL = (LAS float*)(L + RC_MU);
    const float* mu = F.in[14] + (size_t)l * 1792; const float* w_up = F.in[16] + (size_t)l * 64 * 512; const float* a_up = F.in[18] + (size_t)l * 64 * 512; const float* g_up = F.in[19] + (size_t)l * 128 * 512;
    const float w0c = (F.in[15] + l * 512)[hc], a0c = (F.in[17] + l * 512)[hc], kkc = (F.in[20] + l * 512)[hc], kac = (F.in[21] + l * 512)[hc];
    const float* k_k = F.in[20] + l * 512; const float* r_k = F.in[22] + l * 512; const float* ln_w = F.in[23] + l * 512; const float* ln_b = F.in[24] + l * 512;
    const size_t row0 = (size_t)b * SEQ;
    const int nt = wv & 3, half = wv >> 2;
    bf16x8 Bq[4];
    { RC_LANE(); const int hcB = h * 64 + nt * 16 + fr;
    if (half == 0) {
#pragma unroll
        for (int ks = 0; ks < 2; ++ks)
#pragma unroll
            for (int j = 0; j < 8; ++j) { const int k = 32 * ks + 8 * fq + j; Bq[ks][j] = (short)f2bf(w_up[(size_t)k * 512 + hcB]); Bq[2 + ks][j] = (short)f2bf(a_up[(size_t)k * 512 + hcB]); }
    } else {
#pragma unroll
        for (int ks = 0; ks < 4; ++ks)
#pragma unroll
            for (int j = 0; j < 8; ++j) { const int k = 32 * ks + 8 * fq + j; Bq[ks][j] = (short)f2bf(g_up[(size_t)k * 512 + hcB]); }
    } }
    f32x4 ST[4];
#pragma unroll
    for (int kt = 0; kt < 4; ++kt) ST[kt] = (f32x4){0.f, 0.f, 0.f, 0.f};
    for (int c = tid; c < 896; c += NTHR) prevb[c] = 0.f;
    const int t2 = tid - 256, e1i = (t2 >> 4) & 15, lq = t2 & 15;
    v2u cq[14], pq[14]; f32x4 kk4r = {0.f, 0.f, 0.f, 0.f};
#define RC_ZCOLJ(j) (((j) < 3) ? (ZB_R + (j) * 512 + h * 64 + 4 * lq) : (ZB_XW + ((j) - 3) * 64 + 4 * lq))
#define RC_PREFETCH(t0) do { if (wv >= 4) { _Pragma("unroll") for (int s2 = 0; s2 < 2; ++s2) _Pragma("unroll") for (int j = 0; j < 7; ++j) { const int zc = RC_ZCOLJ(j), i = 16 * s2 + e1i; \
        cq[7 * s2 + j] = *(const v2u*)(F.Z() + (row0 + (t0) + i) * NZ + zc); pq[7 * s2 + j] = *(const v2u*)(F.Z() + (row0 + (t0) + (i > 0 ? i - 1 : 0)) * NZ + zc); } } } while (0)
#define RC_E1(pb) do { if (wv >= 4) { _Pragma("unroll") for (int s2 = 0; s2 < 2; ++s2) _Pragma("unroll") for (int j = 0; j < 7; ++j) { const int cc = 64 * j + 4 * lq, i = 16 * s2 + e1i; \
        const v2u cw = cq[7 * s2 + j], pw2 = pq[7 * s2 + j]; \
        float cur[4] = {bflo(cw.x), bfhi(cw.x), bflo(cw.y), bfhi(cw.y)}, prv[4] = {bflo(pw2.x), bfhi(pw2.x), bflo(pw2.y), bfhi(pw2.y)}; \
        if (s2 == 0) { const f32x4 pl = *(const LAS f32x4*)(prevb + (pb) * 448 + cc); if (e1i == 0) { prv[0] = pl[0]; prv[1] = pl[1]; prv[2] = pl[2]; prv[3] = pl[3]; } } \
        if (s2 == 1) { if (e1i == 15) *(LAS f32x4*)(prevb + ((pb) ^ 1) * 448 + cc) = (f32x4){cur[0], cur[1], cur[2], cur[3]}; } \
        const f32x4 m4 = *(const LAS f32x4*)(muL + cc); float zs[4]; _Pragma("unroll") for (int e = 0; e < 4; ++e) zs[e] = cur[e] + (prv[e] - cur[e]) * m4[e]; \
        if (j < 3) { LAS float* d = (j == 0 ? rf : (j == 1 ? kraw : vf)) + i * 64 + 4 * lq; *(LAS f32x4*)d = (f32x4){zs[0], zs[1], zs[2], zs[3]}; \
            if (j == 1) { const f32x4 kk4 = kk4r; float ss = (zs[0] * kk4[0]) * (zs[0] * kk4[0]) + (zs[1] * kk4[1]) * (zs[1] * kk4[1]) + (zs[2] * kk4[2]) * (zs[2] * kk4[2]) + (zs[3] * kk4[3]) * (zs[3] * kk4[3]); \
                ss = sum16(ss); if (lq == 0) RN[i] = __builtin_amdgcn_rsqf(ss + EPS); } } \
        else { float t4[4]; _Pragma("unroll") for (int e = 0; e < 4; ++e) t4[e] = (j == 3) ? ftanh(zs[e]) : ((j == 4) ? zs[e] : fsigmoid(zs[e])); \
            v2u w; w.x = pk2(t4[0], t4[1]); w.y = pk2(t4[2], t4[3]); *(LAS v2u*)(abuf + i * 264 + (j - 3) * 64 + 4 * lq) = w; } } } } while (0)
    const int pc0 = (tid & 15) * 4;
    const f32x4 p_rk = *(const f32x4*)(r_k + h * 64 + pc0), p_lw = *(const f32x4*)(ln_w + h * 64 + pc0), p_lb = *(const f32x4*)(ln_b + h * 64 + pc0);
#define RC_POST(tp) do { int tq = tid; asm volatile("" : "+v"(tq)); const int t = tq >> 4, c0 = (tq & 15) * 4; \
        f32x4 o4 = *(const LAS f32x4*)(OB + t * 64 + c0); const f32x4 r4 = *(const LAS f32x4*)(PR + t * 64 + c0), k4 = *(const LAS f32x4*)(PK + t * 64 + c0), v4 = *(const LAS f32x4*)(PV + t * 64 + c0), g4 = *(const LAS f32x4*)(PG + t * 64 + c0); \
        const float bs = sum16((r4[0] * k4[0] * p_rk[0] + r4[1] * k4[1] * p_rk[1]) + (r4[2] * k4[2] * p_rk[2] + r4[3] * k4[3] * p_rk[3])); \
        const float mean = sum16((o4[0] + o4[1]) + (o4[2] + o4[3])) * (1.f / 64.f); o4 = o4 - mean; \
        const float rstd = __builtin_amdgcn_rsqf(sum16((o4[0] * o4[0] + o4[1] * o4[1]) + (o4[2] * o4[2] + o4[3] * o4[3])) * (1.f / 64.f) + B_LN_EPS); \
        const f32x4 y = (o4 * rstd * p_lw + p_lb + v4 * bs) * g4; \
        v2u w; w.x = pk2(y[0], y[1]); w.y = pk2(y[2], y[3]); *(v2u*)(F.Z() + (row0 + (tp) + t) * NZ + ZB_R + h * 64 + c0) = w; } while (0)
    for (int c = tid; c < 448; c += NTHR) muL[c] = mu[((c < 192) ? ((c >> 6) * 512 + h * 64 + (c & 63)) : (1536 + (c - 192)))];
    if (wv >= 4) kk4r = *(const f32x4*)(k_k + h * 64 + 4 * lq);
    __syncthreads();
    RC_PREFETCH(0);
    RC_E1(0);
    __syncthreads();
    int pb = 1;
    for (int t0 = 0; t0 < SEQ; t0 += 32) {
        if (t0 > 0) RC_POST(t0 - 32);
        if (t0 + 32 < SEQ) RC_PREFETCH(t0 + 32);
        {   RC_LANE();
#pragma unroll
            for (int mt = 0; mt < 2; ++mt) { const LAS bf16* arow = abuf + (16 * mt + fr) * 264 + 8 * fq;
                if (half == 0) { f32x4 aw = {0.f, 0.f, 0.f, 0.f}, aa = aw;
#pragma unroll
                    for (int ks = 0; ks < 2; ++ks) { aw = __builtin_amdgcn_mfma_f32_16x16x32_bf16(*(const LAS bf16x8*)(arow + 32 * ks), Bq[ks], aw, 0, 0, 0);
                        aa = __builtin_amdgcn_mfma_f32_16x16x32_bf16(*(const LAS bf16x8*)(arow + 64 + 32 * ks), Bq[2 + ks], aa, 0, 0, 0); }
#pragma unroll
                    for (int r = 0; r < 4; ++r) { const int tok = 16 * mt + 4 * fq + r, n = nt * 16 + fr; lor[(tok * 3 + 0) * 64 + n] = aw[r]; lor[(tok * 3 + 1) * 64 + n] = aa[r]; }
                } else { f32x4 ag = {0.f, 0.f, 0.f, 0.f};
#pragma unroll
                    for (int ks = 0; ks < 4; ++ks) ag = __builtin_amdgcn_mfma_f32_16x16x32_bf16(*(const LAS bf16x8*)(arow + 128 + 32 * ks), Bq[ks], ag, 0, 0, 0);
#pragma unroll
                    for (int r = 0; r < 4; ++r) { const int tok = 16 * mt + 4 * fq + r, n = nt * 16 + fr; lor[(tok * 3 + 2) * 64 + n] = ag[r]; } } }
        }
        __syncthreads();
        float e_lw[4], e_a[4], e_kn[4], e_kp[4], e_r[4];
        { RC_LANE();
#pragma unroll
        for (int u = 0; u < 4; ++u) { const int t = 4 * wv + u;
            const float wl = lor[(t * 3 + 0) * 64 + lane], al = lor[(t * 3 + 1) * 64 + lane], gl = lor[(t * 3 + 2) * 64 + lane];
            e_lw[u] = -0.6065306597126334f * fsigmoid(w0c + wl);
            e_a[u] = fsigmoid(a0c + al); const float kr = kraw[t * 64 + lane];
            e_kn[u] = kr * kkc * RN[t]; e_kp[u] = kr * (1.f + (e_a[u] - 1.f) * kac); e_r[u] = rf[t * 64 + lane];
            LW[t * 64 + lane] = e_lw[u]; PG[t * 64 + lane] = gl; PV[t * 64 + lane] = vf[t * 64 + lane]; PR[t * 64 + lane] = e_r[u]; PK[t * 64 + lane] = e_kp[u]; } }
        __syncthreads();
        {   RC_LANE(); const int sub = wv >> 2, tl0 = 4 * (wv & 3); float cum = 0.f, c4 = 0.f, c8 = 0.f, c12 = 0.f;
#pragma unroll
            for (int i = 0; i < 16; ++i) { cum += LW[(16 * sub + i) * 64 + lane]; if (i == 3) c4 = cum; if (i == 7) c8 = cum; if (i == 11) c12 = cum; }
            const float cumC = cum; float ct = (tl0 == 0) ? 0.f : ((tl0 == 4) ? c4 : ((tl0 == 8) ? c8 : c12));
            float ah[4], bh[4], kh[4], rh[4], bt[4], kt[4], pv[4];
#pragma unroll
            for (int u = 0; u < 4; ++u) { const int t = 4 * wv + u; ct += e_lw[u];
                const float gm = fexp(ct - e_lw[u]), gi = fexp(-ct), gt = fexp(ct), gr = fexp(cumC - ct);
                ah[u] = -e_kn[u] * gm; bh[u] = e_kn[u] * e_a[u] * gi; kh[u] = e_kp[u] * gi; rh[u] = e_r[u] * gt; bt[u] = e_kn[u] * e_a[u] * gr; kt[u] = e_kp[u] * gr; pv[u] = PV[t * 64 + lane]; }
#pragma unroll
            for (int u2 = 0; u2 < 2; ++u2) { const int t = 4 * wv + 2 * u2;
                const unsigned wa = pk2(ah[2 * u2], ah[2 * u2 + 1]), wb = pk2(bh[2 * u2], bh[2 * u2 + 1]), wk = pk2(kh[2 * u2], kh[2 * u2 + 1]), wr = pk2(rh[2 * u2], rh[2 * u2 + 1]);
                AH[t * 72 + lane] = (bf16)(wa & 0xffffu); AH[(t + 1) * 72 + lane] = (bf16)(wa >> 16); BH[t * 72 + lane] = (bf16)(wb & 0xffffu); BH[(t + 1) * 72 + lane] = (bf16)(wb >> 16);
                KH[t * 72 + lane] = (bf16)(wk & 0xffffu); KH[(t + 1) * 72 + lane] = (bf16)(wk >> 16); RH[t * 72 + lane] = (bf16)(wr & 0xffffu); RH[(t + 1) * 72 + lane] = (bf16)(wr >> 16); }
            {   const int o = sub * 1024 + lane * 16 + tl0;
                *(LAS v2u*)(AHT + o) = (v2u){pk2(ah[0], ah[1]), pk2(ah[2], ah[3])}; *(LAS v2u*)(BTT + o) = (v2u){pk2(bt[0], bt[1]), pk2(bt[2], bt[3])};
                *(LAS v2u*)(KTT + o) = (v2u){pk2(kt[0], kt[1]), pk2(kt[2], kt[3])}; *(LAS v2u*)(VT + o) = (v2u){pk2(pv[0], pv[1]), pk2(pv[2], pv[3])}; }
            if ((wv & 3) == 0) GC[sub * 64 + lane] = fexp(cumC);
        }
        __syncthreads();
        if (wv < 4 && !(F.omask & (1 << 22))) { RC_LANE(); const int e = wv;
#pragma unroll 1
          for (int sub = 0; sub < 2; ++sub) {
            const LAS bf16* AHs = AH + 16 * sub * 72; const LAS bf16* BHs = BH + 16 * sub * 72; const LAS bf16* KHs = KH + 16 * sub * 72; const LAS bf16* RHs = RH + 16 * sub * 72;
            const LAS bf16* AHTs = AHT + sub * 1024; const LAS bf16* BTTs = BTT + sub * 1024; const LAS bf16* KTTs = KTT + sub * 1024; const LAS bf16* VTs = VT + sub * 1024;
            bf16x8 fa[2], fb[2], fk[2], fr8[2];
#pragma unroll
            for (int ks = 0; ks < 2; ++ks) { fa[ks] = *(const LAS bf16x8*)(AHs + fr * 72 + 32 * ks + 8 * fq); fb[ks] = *(const LAS bf16x8*)(BHs + fr * 72 + 32 * ks + 8 * fq);
                fk[ks] = *(const LAS bf16x8*)(KHs + fr * 72 + 32 * ks + 8 * fq); fr8[ks] = *(const LAS bf16x8*)(RHs + fr * 72 + 32 * ks + 8 * fq); }
            const f32x4 z4 = {0.f, 0.f, 0.f, 0.f};
            f32x4 N = z4, NT = z4, Nak = z4, Nrb = z4, Nrk = z4;
#pragma unroll
            for (int ks = 0; ks < 2; ++ks) { N = __builtin_amdgcn_mfma_f32_16x16x32_bf16(fb[ks], fa[ks], N, 0, 0, 0); NT = __builtin_amdgcn_mfma_f32_16x16x32_bf16(fa[ks], fb[ks], NT, 0, 0, 0);
                Nak = __builtin_amdgcn_mfma_f32_16x16x32_bf16(fk[ks], fa[ks], Nak, 0, 0, 0); Nrb = __builtin_amdgcn_mfma_f32_16x16x32_bf16(fb[ks], fr8[ks], Nrb, 0, 0, 0);
                Nrk = __builtin_amdgcn_mfma_f32_16x16x32_bf16(fk[ks], fr8[ks], Nrk, 0, 0, 0); }
#pragma unroll
            for (int r = 0; r < 4; ++r) { const int rw = 4 * fq + r; if (!(rw < fr)) { N[r] = 0.f; Nak[r] = 0.f; } if (!(rw > fr)) NT[r] = 0.f; if (!(rw <= fr)) { Nrb[r] = 0.f; Nrk[r] = 0.f; } }
            const bf16x4s n_ = cvt4(N), nt_ = cvt4(NT);
            const f32x4 N2 = mfma16(nt_, n_, z4), N2T = mfma16(n_, nt_, z4);
            const bf16x4s n2_ = cvt4(N2), n2t_ = cvt4(N2T);
            const f32x4 N4 = mfma16(n2t_, n2_, z4), N4T = mfma16(n2_, n2t_, z4);
            const f32x4 N8 = mfma16(cvt4(N4T), cvt4(N4), z4);
            const f32x4 UT = mfma16(cvt4(add_eye(N2, fq, fr)), cvt4(add_eye(NT, fq, fr)), z4);
            const f32x4 WT = mfma16(cvt4(add_eye(N4, fq, fr)), cvt4(UT), z4);
            const f32x4 T = mfma16(cvt4(WT), cvt4(add_eye(N8, fq, fr)), z4);
            const bf16x4s t_ = cvt4(T);
            bf16x4s p1[4];
#pragma unroll
            for (int kt = 0; kt < 4; ++kt) p1[kt] = cvt4(mfma16(*(const LAS bf16x4s*)(AHTs + (16 * kt + fr) * 16 + 4 * fq), t_, z4));
            const bf16x4s vtf = *(const LAS bf16x4s*)(VTs + (16 * e + fr) * 16 + 4 * fq);
            const f32x4 nakv = mfma16(cvt4(Nak), vtf, z4);
            f32x4 sa = mfma16(t_, cvt4(nakv), z4);
            f32x4 o = mfma16(cvt4(Nrk), vtf, z4);
            bf16x4s sb[4];
#pragma unroll
            for (int kt = 0; kt < 4; ++kt) sb[kt] = cvt4(ST[kt]);
#pragma unroll
            for (int kt = 0; kt < 4; ++kt) { sa = mfma16(p1[kt], sb[kt], sa); o = mfma16(*(const LAS bf16x4s*)(RHs + fr * 72 + 16 * kt + 4 * fq), sb[kt], o); }
            const bf16x4s sab = cvt4(sa);
            o = mfma16(cvt4(Nrb), sab, o);
#pragma unroll
            for (int r = 0; r < 4; ++r) OB[(16 * sub + 4 * fq + r) * 64 + 16 * e + fr] = o[r];
#pragma unroll
            for (int kt = 0; kt < 4; ++kt) { const f32x4 g4 = *(const LAS f32x4*)(GC + 64 * sub + 16 * kt + 4 * fq); f32x4 a = ST[kt] * g4;
                a = mfma16(*(const LAS bf16x4s*)(BTTs + (16 * kt + fr) * 16 + 4 * fq), sab, a); a = mfma16(*(const LAS bf16x4s*)(KTTs + (16 * kt + fr) * 16 + 4 * fq), vtf, a); ST[kt] = a; }
          }
        } else if (t0 + 32 < SEQ && wv >= 4 && !(F.omask & (1 << 23))) { RC_E1(pb); }
        __syncthreads();
        pb ^= 1;
    }
    RC_POST(SEQ - 32);
    if ((F.omask & OM_B_S) && wv < 4) { RC_LANE(); float* o = F.p_b_S() + ((size_t)(l * NB + b) * 8 + h) * 4096;
#pragma unroll
        for (int kt = 0; kt < 4; ++kt) *(f32x4*)(o + (size_t)(16 * wv + fr) * 64 + 16 * kt + 4 * fq) = ST[kt]; }
    __syncthreads();
#undef RC_ZCOLJ
#undef RC_LANE
#undef RC_PREFETCH
#undef RC_E1
#undef RC_POST
}
template <int KIND>
__device__ __forceinline__ void small_gemm(Frame& F, const bf16* A, int lda, const bf16* Bt, int N, int K, const float* xold, float* ssq_out) {
    const int tid = opaque_tid(F), lane = tid & 63, wv = __builtin_amdgcn_readfirstlane(tid >> 6), fq = lane >> 4, fr = lane & 15;
    LAS float* part = (LAS float*)F.lds;
    const int ntiles = 8 * (N / 64), kw = K / 8, nks = kw / 32;
    const int erow = tid >> 3, ec8 = (tid & 7) * 8;
    for (int tile = F.bid; tile < ntiles; tile += F.G) {
        const int rb = tile & 7, cb = tile >> 3; const int row0 = MP + 64 * rb, col0 = 64 * cb;
        float m8[8];
#pragma unroll
        for (int j = 0; j < 8; ++j) m8[j] = 0.f;
        constexpr int NB_ = (KIND == 1) ? 3 : 1;
#pragma unroll 1
        for (int br = 0; br < NB_; ++br) {
            const bf16* Ab = A + (size_t)(row0 + fr) * lda + wv * kw + 8 * fq + ((KIND == 1) ? (br == 0 ? ZA_G : (br == 1 ? ZB_R : ZC_G)) : 0);
            const bf16* Bb = Bt + (size_t)(KIND == 1 ? br * 1024 : 0) * K + (size_t)(col0 + fr) * K + wv * kw + 8 * fq;
            f32x4 acc[4][4];
#pragma unroll
            for (int m = 0; m < 4; ++m)
#pragma unroll
                for (int n = 0; n < 4; ++n) acc[m][n] = (f32x4){0.f, 0.f, 0.f, 0.f};
            bf16x8 a[4], b[4];
#pragma unroll
            for (int u = 0; u < 4; ++u) { a[u] = *(const bf16x8*)(Ab + (size_t)16 * u * lda); b[u] = *(const bf16x8*)(Bb + (size_t)16 * u * K); }
            for (int ks = 1; ks < nks; ++ks) {
                bf16x8 na[4], nb[4];
#pragma unroll
                for (int u = 0; u < 4; ++u) { na[u] = *(const bf16x8*)(Ab + (size_t)16 * u * lda + 32 * ks); nb[u] = *(const bf16x8*)(Bb + (size_t)16 * u * K + 32 * ks); }
#pragma unroll
                for (int m = 0; m < 4; ++m)
#pragma unroll
                    for (int n = 0; n < 4; ++n) acc[m][n] = __builtin_amdgcn_mfma_f32_16x16x32_bf16(a[m], b[n], acc[m][n], 0, 0, 0);
#pragma unroll
                for (int u = 0; u < 4; ++u) { a[u] = na[u]; b[u] = nb[u]; }
            }
#pragma unroll
            for (int m = 0; m < 4; ++m)
#pragma unroll
                for (int n = 0; n < 4; ++n) acc[m][n] = __builtin_amdgcn_mfma_f32_16x16x32_bf16(a[m], b[n], acc[m][n], 0, 0, 0);
#pragma unroll
            for (int m = 0; m < 4; ++m)
#pragma unroll
                for (int n = 0; n < 4; ++n)
#pragma unroll
                    for (int r = 0; r < 4; ++r) part[wv * 4096 + (16 * m + 4 * fq + r) * 64 + 16 * n + fr] = acc[m][n][r];
            __syncthreads();
            float v[8];
#pragma unroll
            for (int j = 0; j < 8; ++j) v[j] = 0.f;
#pragma unroll
            for (int w = 0; w < 8; ++w) { const f32x4 p0 = *(const LAS f32x4*)(part + w * 4096 + erow * 64 + ec8), p1 = *(const LAS f32x4*)(part + w * 4096 + erow * 64 + ec8 + 4);
                v[0] += p0[0]; v[1] += p0[1]; v[2] += p0[2]; v[3] += p0[3]; v[4] += p1[0]; v[5] += p1[1]; v[6] += p1[2]; v[7] += p1[3]; }
            if (KIND == 1) { const int col = col0 + ec8; const v4u gw = *(const v4u*)(F.Z() + (size_t)(row0 + erow) * NZ + pg8::gate_col(br * 4 + (col >> 8)) + (col & 255));
                m8[0] += bflo(gw.x) * v[0]; m8[1] += bfhi(gw.x) * v[1]; m8[2] += bflo(gw.y) * v[2]; m8[3] += bfhi(gw.y) * v[3];
                m8[4] += bflo(gw.z) * v[4]; m8[5] += bfhi(gw.z) * v[5]; m8[6] += bflo(gw.w) * v[6]; m8[7] += bfhi(gw.w) * v[7]; }
            else {
#pragma unroll
                for (int j = 0; j < 8; ++j) m8[j] = v[j]; }
            __syncthreads();
        }
        const int row = row0 + erow, col = col0 + ec8;
        if (KIND == 0 || KIND == 3) { const float rs = pg8::row_rstd(F.SSQ(), row); float o[8];
#pragma unroll
            for (int j = 0; j < 8; ++j) { float x = m8[j] * rs; if (KIND == 0) x = fsigmoid(x); else { x = fmaxf(x, 0.f); x = x * x; } o[j] = x; }
            v4u w; w.x = pg8::cvt_pk_bf16(o[0], o[1]); w.y = pg8::cvt_pk_bf16(o[2], o[3]); w.z = pg8::cvt_pk_bf16(o[4], o[5]); w.w = pg8::cvt_pk_bf16(o[6], o[7]);
            if (KIND == 0) *(v4u*)(F.Z() + (size_t)row * NZ + pg8::gate_col(col >> 8) + (col & 255)) = w; else *(v4u*)(F.Z() + (size_t)row * DFF + col) = w;
        } else if (KIND == 1) {
            v4u w; w.x = pg8::cvt_pk_bf16(m8[0], m8[1]); w.y = pg8::cvt_pk_bf16(m8[2], m8[3]); w.z = pg8::cvt_pk_bf16(m8[4], m8[5]); w.w = pg8::cvt_pk_bf16(m8[6], m8[7]);
            *(v4u*)(F.Mb() + (size_t)row * D + col) = w;
        } else {
            const f32x4* xo = (const f32x4*)(xold + (size_t)(row - MP) * D + col); const f32x4 x0 = xo[0] + (f32x4){m8[0], m8[1], m8[2], m8[3]}, x1 = xo[1] + (f32x4){m8[4], m8[5], m8[6], m8[7]};
            f32x4* yo = (f32x4*)(F.y_x() + (size_t)row * D + col); yo[0] = x0; yo[1] = x1;
            v4u w; w.x = pg8::cvt_pk_bf16(x0[0], x0[1]); w.y = pg8::cvt_pk_bf16(x0[2], x0[3]); w.z = pg8::cvt_pk_bf16(x1[0], x1[1]); w.w = pg8::cvt_pk_bf16(x1[2], x1[3]);
            *(v4u*)(F.XB() + (size_t)row * D + col) = w;
            float ss = (x0[0] * x0[0] + x0[1] * x0[1]) + (x0[2] * x0[2] + x0[3] * x0[3]) + (x1[0] * x1[0] + x1[1] * x1[1]) + (x1[2] * x1[2] + x1[3] * x1[3]);
            ss = sum8(ss); if ((tid & 7) == 0) ssq_out[(size_t)row * 16 + cb] = ss;
        }
    }
}
struct Args { const float* in[38]; float* out; unsigned char* ws; int ph_lo, ph_hi, omask, pad; };
constexpr int PH_PER_LAYER = 10, PH_FINAL = 2 * PH_PER_LAYER, PH_END = PH_FINAL + 1;
constexpr int CW_BAR = 4096;

__global__ void __launch_bounds__(NTHR, 2) hybrid_fwd(Args args) {
    extern __shared__ __attribute__((aligned(16))) unsigned char lds_raw[];
    Frame F;
    F.lds = (LAS unsigned char*)lds_raw;
    F.tid = threadIdx.x; F.lane = F.tid & 63; F.wave = __builtin_amdgcn_readfirstlane(F.tid >> 6);
    F.G = gridDim.x; F.bid = blockIdx.x; F.omask = args.omask;
    static_assert(offsetof(Args, out) == 304 && offsetof(Args, ws) == 312, "kernarg layout used by LAUNDER");
    { const CAS unsigned char* _kp = (const CAS unsigned char*)__builtin_amdgcn_kernarg_segment_ptr(); F.in = (const float* const CAS*)_kp; F.out = args.out; F.ws = args.ws; }
    unsigned char* ws = args.ws;
    volatile LAS unsigned* MISC = (volatile LAS unsigned*)(F.lds + MISC_OFF);
    if (F.tid < 64) MISC[F.tid] = 0u;
    __syncthreads();
    { const unsigned xcc = xb_xcc_id(); if (threadIdx.x == 0) { (void)xb_add(&((unsigned*)(ws + WS_CTL) + CW_BAR)[XB_XCNT(xcc)], 1u);
        if (F.G <= 64 || F.bid >= 64) (void)xb_add(&((unsigned*)(ws + WS_CTL) + CW_BAR + XCD_BAR_WORDS)[XB_XCNT(xcc)], 1u);
        if (F.G > 128 && F.bid >= 96) (void)xb_add(&((unsigned*)(ws + WS_CTL) + CW_BAR + 2 * XCD_BAR_WORDS)[XB_XCNT(xcc)], 1u); } }
    const int lo = args.ph_lo, hi = args.ph_hi;
    const int G = F.G, bid = F.bid;

#define LAUNDER() do { int _t = threadIdx.x; asm volatile("" : "+v"(_t)); F.tid = _t; F.lane = _t & 63; F.wave = __builtin_amdgcn_readfirstlane(_t >> 6); \
        const CAS unsigned char* _kp = (const CAS unsigned char*)__builtin_amdgcn_kernarg_segment_ptr(); asm volatile("" : "+s"(_kp)); \
        F.in = (const float* const CAS*)_kp; F.out = *(float* const CAS*)(_kp + 304); F.ws = *(unsigned char* const CAS*)(_kp + 312); } while (0)
#define MAIN_BAR() do { XcdBarrier _b; _b.bar = (unsigned*)(args.ws + WS_CTL) + CW_BAR; _b.x = xb_xcc_id(); _b.st = (volatile LAS unsigned*)(F.lds + MISC_OFF) + 8; _b.nparts = (unsigned)G; xcd_barrier(_b); } while (0)
#define PHASE_BEGIN(p) if (lo <= (p) && (p) < hi && !((args.omask & 512) && ((p) % 10 >= 2 && (p) % 10 <= 4)) && !((args.omask & 1024) && (p) % 10 == 1)) { if ((p) > lo) MAIN_BAR(); LAUNDER();
#define PHASE_END }
    if (args.omask & (1 << 24)) { for (int i = 0; i < 16; ++i) MAIN_BAR(); }
    for (int l = 0; l < 2; ++l) {
        const int p0 = l * PH_PER_LAYER;
        PHASE_BEGIN(p0 + 0) p0_weights(F, l); if (l == 0) p0_xb(F); PHASE_END
        PHASE_BEGIN(p0 + 1)
            pg8::Gemm g{F.XB(), D, F.WIN(), D}; pg8::Order S; S.init(MROWS, NZ, G, bid, 1, (size_t)256 * D * 2, (size_t)256 * D * 2);
            pg8::EpiRowScale<0> E{F.Z(), NZ, F.SSQ(), F.lds};
            pg8::gemm_phase<pg8::EpiRowScale<0>, pg8::Order, true, true>(F.lds, g, S, E);
        PHASE_END
        PHASE_BEGIN(p0 + 2) p2_misc(F, l); PHASE_END
        PHASE_BEGIN(p0 + 3)
            if (bid < 64 && !(args.omask & 2048)) { const int b = bid >> 3, h = bid & 7;
                rwkv_chain_chunked(F, l, b, h); }
            const bool few = (G <= 64); const bool in_sub = few || bid >= 64; const int me = few ? bid : bid - 64, np = few ? G : G - 64;
            if (in_sub) {
#define SUB_BAR() do { XcdBarrier barB; barB.bar = (unsigned*)(F.ws + WS_CTL) + CW_BAR + XCD_BAR_WORDS; barB.x = xb_xcc_id(); barB.st = (volatile LAS unsigned*)(F.lds + MISC_OFF) + 10; barB.nparts = (unsigned)np; xcd_barrier(barB); LAUNDER(); } while (0)
                const int skip = (args.omask >> 13) & 15; const bool do_items = !(args.omask & 4096), do_p2 = (lo <= p0 + 4 && p0 + 4 < hi && !(args.omask & (1 << 20)));
                constexpr int N_AP = NB * 32 * 4, N_CP = NB * 32, N_CS = 8, N_GS = NSB * 4, N_RS = NSB * 8;
                if (do_items && !(skip & 1)) { int cur_h = -1; for (int it = me; it < N_AP; it += np) { const int h = it & 3; if (h != cur_h) { gdn_prep_weights(F, l, h); cur_h = h; } gdn_prep_unit(F, l, it >> 7, (it >> 2) & 31, h); } }
                SUB_BAR();
                const int nscan = (np > 64) ? 32 : 0;
                if (me < nscan) { if (do_p2) gdn_scan_unit(F, l, me >> 2, me & 3); }
                else if (do_items) { for (int it = me - nscan; it < N_CP + N_CS + N_GS + N_RS; it += np - nscan) { int r = it;
                    if (r < N_CP) { if (!(skip & 2)) rglru_prep_unit<false>(F, l, r >> 5, r & 31); continue; } r -= N_CP;
                    if (r < N_CS) { if (!(skip & 2)) rglru_prep_unit<true>(F, l, r, 0); continue; } r -= N_CS;
                    if (r < N_GS) { if (!(skip & 4)) gdn_sample_unit(F, l, r >> 2, r & 3); continue; } r -= N_GS;
                    if (!(skip & 8)) { const int sb = r >> 3, h = r & 7;
                      rwkv_unit(F, l, MP + sb * TS, TS, h, F.in[4] + (((size_t)l * NSB + sb) * 8 + h) * 4096, F.in[5] + ((size_t)l * NSB + sb) * 1792, F.s_b_S() + (((size_t)l * NSB + sb) * 8 + h) * 4096); } } }
                if (nscan == 0) { if (do_p2) for (int it = me; it < 32; it += np) gdn_scan_unit(F, l, it >> 2, it & 3);
                    SUB_BAR();
                    if (do_p2) for (int it = me; it < NB * 32; it += np) rglru_fix_unit(F, l, it >> 5, it & 31); }
                else if (me >= nscan) {
                    { XcdBarrier barC; barC.bar = (unsigned*)(F.ws + WS_CTL) + CW_BAR + 2 * XCD_BAR_WORDS; barC.x = xb_xcc_id(); barC.st = (volatile LAS unsigned*)(F.lds + MISC_OFF) + 12; barC.nparts = (unsigned)(np - nscan); xcd_barrier(barC); LAUNDER(); }
                    if (do_p2) for (int it = me - nscan; it < NB * 32; it += np - nscan) rglru_fix_unit(F, l, it >> 5, it & 31); }
#undef SUB_BAR
            }
        PHASE_END
        PHASE_BEGIN(p0 + 5)
            pg8::Gemm g{F.XB(), D, F.WIN() + (size_t)NZ * D, D}; pg8::Order S; S.init(MP, NGATE, G, bid, 1, (size_t)256 * D * 2, (size_t)256 * D * 2);
            pg8::EpiRowScale<1> E{F.Z(), NZ, F.SSQ(), F.lds};
            pg8::gemm_phase<pg8::EpiRowScale<1>, pg8::Order, true, true>(F.lds, g, S, E);
            if (!(args.omask & (1 << 25))) small_gemm<0>(F, F.XB(), D, F.WIN() + (size_t)NZ * D, NGATE, D, nullptr, nullptr);
        PHASE_END
        PHASE_BEGIN(p0 + 6)
            static_assert(ZA_G * 2 == 3072 && ZB_R * 2 == 4096 && ZC_G * 2 == 8704, "branch A-operand column offsets are hard-wired in pg8::Order::next");
            pg8::Gemm g{F.Z(), NZ, F.WBR(), 512}; pg8::Order S; S.init(MP, D, G, bid, 3, (size_t)256 * NZ * 2, (size_t)256 * 512 * 2);
            pg8::EpiBranch E{F.Mb(), F.Z(), NZ};
            pg8::gemm_phase<pg8::EpiBranch, pg8::Order, true, true>(F.lds, g, S, E);
            if (!(args.omask & (1 << 25))) small_gemm<1>(F, F.Z(), NZ, F.WBR(), D, 512, nullptr, nullptr);
        PHASE_END
        PHASE_BEGIN(p0 + 7)
            pg8::Gemm g{F.Mb(), D, F.WOUT(), D}; pg8::Order S; S.init(MP, D, G, bid, 1, (size_t)256 * D * 2, (size_t)256 * D * 2);
            pg8::EpiRes E{l == 0 ? F.in[0] : F.y_x(), l == 0 ? F.in[1] : F.y_x() + (size_t)MP * D, F.y_x(), F.XB(), F.SSQ()};
            pg8::gemm_phase<pg8::EpiRes, pg8::Order, true, true>(F.lds, g, S, E);
            if (!(args.omask & (1 << 25))) small_gemm<2>(F, F.Mb(), D, F.WOUT(), D, D, l == 0 ? F.in[1] : F.y_x() + (size_t)MP * D, F.SSQ());
        PHASE_END
        PHASE_BEGIN(p0 + 8)
            pg8::Gemm g{F.XB(), D, F.WUP(), D}; pg8::Order S; S.init(MP, DFF, G, bid, 1, (size_t)256 * D * 2, (size_t)256 * D * 2);
            pg8::EpiRowScale<2> E{F.Z(), DFF, F.SSQ(), F.lds};
            pg8::gemm_phase<pg8::EpiRowScale<2>, pg8::Order, true, true>(F.lds, g, S, E);
            if (!(args.omask & (1 << 25))) small_gemm<3>(F, F.XB(), D, F.WUP(), DFF, D, nullptr, nullptr);
        PHASE_END
        PHASE_BEGIN(p0 + 9)
            pg8::Gemm g{F.Z(), DFF, F.WDN(), DFF}; pg8::Order S; S.init(MP, D, G, bid, 1, (size_t)256 * DFF * 2, (size_t)256 * DFF * 2);
            pg8::EpiRes E{F.y_x(), F.y_x() + (size_t)MP * D, F.y_x(), F.XB(), F.SSQ()};
            pg8::gemm_phase<pg8::EpiRes, pg8::Order, true, true>(F.lds, g, S, E);
            if (!(args.omask & (1 << 25))) small_gemm<2>(F, F.Z(), DFF, F.WDN(), D, DFF, F.y_x() + (size_t)MP * D, F.SSQ());
        PHASE_END
    }
    if (args.omask & 256) { MAIN_BAR(); LAUNDER();
        const int c0 = args.omask >> 16; const int gw = bid * NWAVES + F.wave, NGW = G * NWAVES;
        for (int m = gw; m < MROWS; m += NGW) { const bf16* src = (c0 == 9999) ? F.Mb() + (size_t)m * D : F.Z() + (size_t)m * NZ + c0; float* dst = F.y_x() + (size_t)m * D;
            for (int j = F.lane; j < D / 2; j += 64) { const unsigned w = ((const unsigned*)src)[j]; dst[2 * j] = bflo(w); dst[2 * j + 1] = bfhi(w); } }
    }
    if ((lo <= PH_FINAL && PH_FINAL < hi) || (args.omask & 128)) { MAIN_BAR(); LAUNDER();
        const float* fg = F.in[37]; const int gw = bid * NWAVES + F.wave, NGW = G * NWAVES;
        for (int m = gw; m < MROWS; m += NGW) { f32x4* xp = (f32x4*)(F.y_x() + (size_t)m * D) + F.lane * 4; f32x4 v[4]; float s = 0.f;
#pragma unroll
            for (int j = 0; j < 4; ++j) { v[j] = xp[j]; s += (v[j][0] * v[j][0] + v[j][1] * v[j][1]) + (v[j][2] * v[j][2] + v[j][3] * v[j][3]); }
            const float rs = __builtin_amdgcn_rsqf(wave_sum(s) * (1.f / D) + EPS);
#pragma unroll
            for (int j = 0; j < 4; ++j) { const f32x4 gg = ((const f32x4*)fg)[F.lane * 4 + j]; xp[j] = v[j] * rs * gg; } }
    PHASE_END
#undef LAUNDER
#undef MAIN_BAR
#undef PHASE_BEGIN
#undef PHASE_END
}

static int fast_launch(void* const* d_in, void* d_out, void* d_ws, size_t ws_size, hipStream_t stream, int ph_lo, int ph_hi, int omask) {
    static int grid = 0;
    if (grid == 0) {
        if (ws_size < WS_END) { fprintf(stderr, "kernel_launch: needs %zu bytes of workspace, got %zu\n", (size_t)WS_END, ws_size); grid = -1; return -1; }
        int dev = 0, cus = 0, per_cu = 0;
        if (hipGetDevice(&dev) != hipSuccess || hipDeviceGetAttribute(&cus, hipDeviceAttributeMultiprocessorCount, dev) != hipSuccess) { grid = -1; return -1; }
        if (hipFuncSetAttribute((const void*)hybrid_fwd, hipFuncAttributeMaxDynamicSharedMemorySize, LDS_BYTES) != hipSuccess) { fprintf(stderr, "kernel_launch: hipFuncSetAttribute failed\n"); grid = -1; return -1; }
        if (hipOccupancyMaxActiveBlocksPerMultiprocessor(&per_cu, (const void*)hybrid_fwd, NTHR, LDS_BYTES) != hipSuccess || per_cu < 1) fprintf(stderr, "kernel_launch: occupancy query says %d blocks per CU\n", per_cu);
        (void)hipGetLastError();
        grid = cus;
        fprintf(stderr, "kernel_launch: grid %d, ws %zu\n", grid, ws_size);
    }
    if (grid < 0) return -1;
    if (hipMemsetAsync((char*)d_ws + WS_CTL, 0, CTL_ZERO_BYTES, stream) != hipSuccess) return -1;
    Args a{};
    for (int i = 0; i < 38; ++i) a.in[i] = (const float*)d_in[i];
    a.out = (float*)d_out; a.ws = (unsigned char*)d_ws; a.ph_lo = ph_lo; a.ph_hi = ph_hi; a.omask = omask; a.pad = 0;
    hipLaunchKernelGGL(hybrid_fwd, dim3(grid), dim3(NTHR), LDS_BYTES, stream, a);
    return 0;
}
extern "C" void kernel_launch(void* const* d_in, const int* in_sizes, int n_in, void* d_out, int out_size, void* d_ws, size_t ws_size, hipStream_t stream) {
    fast_launch(d_in, d_out, d_ws, ws_size, stream, 0, 21, 127);
}
```
